# Optimizing an MI355X kernel written in HIP

```python
import math
import jax
import jax.numpy as jnp
from jax import lax
import numpy as np

D_MODEL = 1024
BATCH = 1
SEQ = 16384
DEPTH = 2
DEC_BATCH = 8
DEC_SEQ = 64
PAST_LEN = 4096

CHUNK = 64
Q_BLOCK = 128
EPS = 1e-6
NEG_INF = -1e30

A_HEADS = 8
A_HEAD_DIM = 64
A_VDIM = 2 * A_HEAD_DIM
A_QK = A_HEADS * A_VDIM
A_WIDTH = A_HEADS * A_VDIM

B_HEADS = 8
B_DK = 128
B_DV = 128
B_WIDTH = B_HEADS * B_DV
B_QKV = B_HEADS * (2 * B_DK + B_DV)
GDN_CONV = 4
GDN_CHUNK = CHUNK

D_FF = 2816
FFN_CONV = 3

COL_QA = A_QK
COL_KA = COL_QA + A_QK
COL_VA = COL_KA + A_WIDTH
COL_QKVB = COL_VA + B_QKV
COL_BETA = COL_QKVB + B_HEADS
COL_ALPHA = COL_BETA + B_HEADS
COL_Z = COL_ALPHA + B_WIDTH
COL_GA = COL_Z + D_MODEL
IN_COLS = COL_GA + D_MODEL
COL_SPLITS = (COL_QA, COL_KA, COL_VA, COL_QKVB, COL_BETA, COL_ALPHA, COL_Z, COL_GA)

kernel_name = 'hybrid_diffattn_gdn_stream_step'


def rmsnorm(x, g):
    xf = x.astype(jnp.float32)
    y = xf * lax.rsqrt(jnp.mean(xf * xf, axis=-1, keepdims=True) + EPS)
    return (y * g.astype(jnp.float32)).astype(x.dtype)


def l2norm(x):
    xf = x.astype(jnp.float32)
    return xf * lax.rsqrt(jnp.sum(xf * xf, axis=-1, keepdims=True) + EPS)


def lambda_init(layer):
    return 0.8 - 0.6 * math.exp(-0.3 * layer)


def causal_dwconv(x, buf, w, b=None):
    width = w.shape[0]
    t = x.shape[1]
    xp = jnp.concatenate([buf.astype(x.dtype), x], axis=1)
    y = xp[:, 0:t] * w[0]
    for j in range(1, width):
        y = y + xp[:, j:j + t] * w[j]
    if b is not None:
        y = y + b
    return y, xp[:, xp.shape[1] - (width - 1):]


def diff_attention(q, k, v, q_start, lam, lam_init, subln_g):
    bsz, t = q.shape[0], q.shape[1]
    n_keys = k.shape[1]
    qb = min(t, Q_BLOCK)
    nblk = t // qb
    k5 = k.reshape(bsz, n_keys, A_HEADS, 2, A_HEAD_DIM)
    k_pos = jnp.arange(n_keys)
    slopes = 2.0 ** (-8.0 * jnp.arange(1, A_HEADS + 1, dtype=jnp.float32) / A_HEADS)
    scale = A_HEAD_DIM ** -0.5
    qs = q.reshape(bsz, nblk, qb, A_HEADS, 2, A_HEAD_DIM).transpose(1, 0, 2, 3, 4, 5)
    starts = q_start + jnp.arange(nblk) * qb

    def block(args):
        qblk, start = args
        q_pos = start + jnp.arange(qb)
        s = jnp.einsum('bqhmd,bkhmd->bmhqk', qblk, k5).astype(jnp.float32) * scale
        dist = jnp.abs(q_pos[:, None] - k_pos[None, :]).astype(jnp.float32)
        visible = (k_pos[None, :] // CHUNK) <= (q_pos[:, None] // CHUNK)
        s = s - slopes[:, None, None] * dist
        s = jnp.where(visible, s, NEG_INF)
        p = jax.nn.softmax(s, axis=-1)
        p = p[:, 0] - lam * p[:, 1]
        return jnp.einsum('bhqk,bkhe->bqhe', p.astype(v.dtype), v)

    o = lax.map(block, (qs, starts))
    o = o.transpose(1, 0, 2, 3, 4).reshape(bsz, t, A_HEADS, A_VDIM)
    o = rmsnorm(o, subln_g) * (1.0 - lam_init)
    return o.reshape(bsz, t, A_WIDTH)


def gdn_chunk_step(S, inp):
    q, k, v, beta, g = inp
    c = q.shape[2]
    G = jnp.cumsum(g, axis=-1)
    incl = jnp.tril(jnp.ones((c, c), dtype=bool))
    strict = jnp.tril(jnp.ones((c, c), dtype=bool), -1)
    decay = jnp.where(incl, jnp.exp(jnp.where(incl, G[..., :, None] - G[..., None, :], 0.0)), 0.0)
    kb = k * beta[..., None]
    L = jnp.where(strict, jnp.einsum('bhid,bhjd->bhij', kb, k) * decay, 0.0)
    rhs = jnp.concatenate([v * beta[..., None], kb * jnp.exp(G)[..., None]], axis=-1)
    sol = lax.linalg.triangular_solve(L + jnp.eye(c, dtype=jnp.float32), rhs,
                                      left_side=True, lower=True, unit_diagonal=True)
    u, w = sol[..., :B_DV], sol[..., B_DV:]
    v_new = u - jnp.einsum('bhck,bhkv->bhcv', w, S)
    attn = jnp.einsum('bhid,bhjd->bhij', q, k) * decay
    o = (jnp.einsum('bhck,bhkv->bhcv', q * jnp.exp(G)[..., None], S)
         + jnp.einsum('bhij,bhjv->bhiv', attn, v_new))
    g_last = G[..., -1:]
    S_new = (S * jnp.exp(g_last)[..., None]
             + jnp.einsum('bhck,bhcv->bhkv', k * jnp.exp(g_last - G)[..., None], v_new))
    return S_new, o


def gdn_scan(S0, q, k, v, beta, g):
    bsz, t = q.shape[0], q.shape[1]
    c = min(t, GDN_CHUNK)
    n = t // c

    def chunks(a):
        a = a.reshape((bsz, n, c) + a.shape[2:])
        return jnp.swapaxes(jnp.swapaxes(a, 0, 1), 2, 3)

    S, o = lax.scan(gdn_chunk_step, S0, (chunks(q), chunks(k), chunks(v), chunks(beta), chunks(g)))
    o = o.transpose(1, 0, 3, 2, 4).reshape(bsz, t, B_HEADS, B_DV)
    return S, o


def trunk_layer(x, l, k_past, v_past, gdn_state, gdn_buf, ffn_buf, W):
    bsz, t, _ = x.shape
    xn = rmsnorm(x, W['norm_mix_g'][l])
    proj = xn @ W['w_in'][l]
    qa, ka, va, qkv_b, b_raw, a_raw, z, ga, gb = jnp.split(proj, COL_SPLITS, axis=-1)

    qa = qa.reshape(bsz, t, A_HEADS, A_VDIM)
    ka = ka.reshape(bsz, t, A_HEADS, A_VDIM)
    va = va.reshape(bsz, t, A_HEADS, A_VDIM)
    if k_past is None:
        k_all, v_all, past = ka, va, 0
    else:
        k_all = jnp.concatenate([k_past.astype(ka.dtype), ka], axis=1)
        v_all = jnp.concatenate([v_past.astype(va.dtype), va], axis=1)
        past = k_past.shape[1]
    lam0 = lambda_init(l)
    lq1 = W['lambda_q1'][l].astype(jnp.float32)
    lk1 = W['lambda_k1'][l].astype(jnp.float32)
    lq2 = W['lambda_q2'][l].astype(jnp.float32)
    lk2 = W['lambda_k2'][l].astype(jnp.float32)
    lam = jnp.exp(jnp.sum(lq1 * lk1)) - jnp.exp(jnp.sum(lq2 * lk2)) + lam0
    o_a = diff_attention(qa, k_all, v_all, past, lam, lam0, W['subln_g'][l])

    conv_out, new_gdn_buf = causal_dwconv(qkv_b, gdn_buf, W['gdn_conv_w'][l])
    conv_out = jax.nn.silu(conv_out)
    qb_, kb_, vb_ = jnp.split(conv_out, (B_HEADS * B_DK, 2 * B_HEADS * B_DK), axis=-1)
    qb_ = l2norm(qb_.reshape(bsz, t, B_HEADS, B_DK)) * (B_DK ** -0.5)
    kb_ = l2norm(kb_.reshape(bsz, t, B_HEADS, B_DK))
    vb_ = vb_.reshape(bsz, t, B_HEADS, B_DV).astype(jnp.float32)
    beta = jax.nn.sigmoid(b_raw.astype(jnp.float32))
    g = -jnp.exp(W['gdn_a_log'][l].astype(jnp.float32)) * jax.nn.softplus(
        a_raw.astype(jnp.float32) + W['gdn_dt_bias'][l].astype(jnp.float32))
    S_new, o_b = gdn_scan(gdn_state.astype(jnp.float32), qb_, kb_, vb_, beta, g)
    o_b = rmsnorm(o_b, W['gdn_norm_g'][l]) * jax.nn.silu(
        z.reshape(bsz, t, B_HEADS, B_DV).astype(jnp.float32))
    o_b = o_b.astype(x.dtype).reshape(bsz, t, B_WIDTH)

    merged = (jax.nn.sigmoid(ga) * (o_a @ W['w_proj_a'][l])
              + jax.nn.sigmoid(gb) * (o_b @ W['w_proj_b'][l]))
    h = x + merged @ W['w_out'][l]

    hn = rmsnorm(h, W['norm_ffn_g'][l])
    u = hn @ W['w_up'][l]
    u_c, new_ffn_buf = causal_dwconv(u, ffn_buf, W['ffn_conv_w'][l], W['ffn_conv_b'][l])
    gate, val = jnp.split(u_c, 2, axis=-1)
    y = h + (jax.nn.silu(gate) * val) @ W['w_down'][l]
    return y, ka, va, S_new.astype(x.dtype), new_gdn_buf, new_ffn_buf


def setup_inputs(seed: int = 0) -> dict:
    key = jax.random.key(seed)
    ks = jax.random.split(key, 32)
    f32 = jnp.float32

    def nrm(k, shape, scale):
        return jax.random.normal(k, shape, f32) * scale

    dt = jnp.exp(jax.random.uniform(ks[14], (DEPTH, B_HEADS), f32, math.log(1e-3), math.log(1e-1)))
    return {
        'x_prompt': nrm(ks[0], (BATCH, SEQ, D_MODEL), 1.0),
        'x_sample': nrm(ks[1], (DEC_BATCH, DEC_SEQ, D_MODEL), 1.0),
        'cache_k': nrm(ks[2], (DEPTH, DEC_BATCH, PAST_LEN, A_HEADS, A_VDIM), 1.0),
        'cache_v': nrm(ks[3], (DEPTH, DEC_BATCH, PAST_LEN, A_HEADS, A_VDIM), 1.0),
        'state_gdn': nrm(ks[4], (DEPTH, DEC_BATCH, B_HEADS, B_DK, B_DV), 0.1),
        'state_gdn_conv': nrm(ks[5], (DEPTH, DEC_BATCH, GDN_CONV - 1, B_QKV), 1.0),
        'state_ffn_conv': nrm(ks[6], (DEPTH, DEC_BATCH, FFN_CONV - 1, 2 * D_FF), 1.0),
        'norm_mix_g': 1.0 + nrm(ks[7], (DEPTH, D_MODEL), 0.02),
        'w_in': nrm(ks[8], (DEPTH, D_MODEL, IN_COLS), D_MODEL ** -0.5),
        'lambda_q1': nrm(ks[9], (DEPTH, A_HEAD_DIM), 0.1),
        'lambda_k1': nrm(ks[10], (DEPTH, A_HEAD_DIM), 0.1),
        'lambda_q2': nrm(ks[11], (DEPTH, A_HEAD_DIM), 0.1),
        'lambda_k2': nrm(ks[12], (DEPTH, A_HEAD_DIM), 0.1),
        'subln_g': 1.0 + nrm(ks[13], (DEPTH, A_VDIM), 0.02),
        'gdn_conv_w': nrm(ks[15], (DEPTH, GDN_CONV, B_QKV), GDN_CONV ** -0.5),
        'gdn_a_log': jnp.log(jax.random.uniform(ks[16], (DEPTH, B_HEADS), f32, 1.0, 16.0)),
        'gdn_dt_bias': dt + jnp.log(-jnp.expm1(-dt)),
        'gdn_norm_g': 1.0 + nrm(ks[17], (DEPTH, B_DV), 0.02),
        'w_proj_a': nrm(ks[18], (DEPTH, A_WIDTH, D_MODEL), A_WIDTH ** -0.5),
        'w_proj_b': nrm(ks[19], (DEPTH, B_WIDTH, D_MODEL), B_WIDTH ** -0.5),
        'w_out': nrm(ks[20], (DEPTH, D_MODEL, D_MODEL), D_MODEL ** -0.5),
        'norm_ffn_g': 1.0 + nrm(ks[21], (DEPTH, D_MODEL), 0.02),
        'w_up': nrm(ks[22], (DEPTH, D_MODEL, 2 * D_FF), D_MODEL ** -0.5),
        'ffn_conv_w': nrm(ks[23], (DEPTH, FFN_CONV, 2 * D_FF), FFN_CONV ** -0.5),
        'ffn_conv_b': nrm(ks[24], (DEPTH, 2 * D_FF), 0.01),
        'w_down': nrm(ks[25], (DEPTH, D_FF, D_MODEL), D_FF ** -0.5),
        'final_norm_g': 1.0 + nrm(ks[26], (D_MODEL,), 0.02),
    }


def reference(x_prompt, x_sample, cache_k, cache_v, state_gdn, state_gdn_conv, state_ffn_conv,
              norm_mix_g, w_in, lambda_q1, lambda_k1, lambda_q2, lambda_k2, subln_g,
              gdn_conv_w, gdn_a_log, gdn_dt_bias, gdn_norm_g, w_proj_a, w_proj_b, w_out,
              norm_ffn_g, w_up, ffn_conv_w, ffn_conv_b, w_down, final_norm_g):
    W = dict(norm_mix_g=norm_mix_g, w_in=w_in, lambda_q1=lambda_q1, lambda_k1=lambda_k1,
             lambda_q2=lambda_q2, lambda_k2=lambda_k2, subln_g=subln_g, gdn_conv_w=gdn_conv_w,
             gdn_a_log=gdn_a_log, gdn_dt_bias=gdn_dt_bias, gdn_norm_g=gdn_norm_g,
             w_proj_a=w_proj_a, w_proj_b=w_proj_b, w_out=w_out, norm_ffn_g=norm_ffn_g,
             w_up=w_up, ffn_conv_w=ffn_conv_w, ffn_conv_b=ffn_conv_b, w_down=w_down)

    xp = x_prompt
    bp = xp.shape[0]
    kp, vp, sp, gcp, fcp = [], [], [], [], []
    for l in range(DEPTH):
        s0 = jnp.zeros((bp, B_HEADS, B_DK, B_DV), jnp.float32)
        gbuf0 = jnp.zeros((bp, GDN_CONV - 1, B_QKV), xp.dtype)
        fbuf0 = jnp.zeros((bp, FFN_CONV - 1, 2 * D_FF), xp.dtype)
        xp, k_new, v_new, s_new, gc_new, fc_new = trunk_layer(xp, l, None, None, s0, gbuf0, fbuf0, W)
        kp.append(k_new); vp.append(v_new); sp.append(s_new); gcp.append(gc_new); fcp.append(fc_new)
    y_prompt = rmsnorm(xp, final_norm_g)

    xs = x_sample
    ksm, vsm, ssm, gcs, fcs = [], [], [], [], []
    for l in range(DEPTH):
        xs, k_new, v_new, s_new, gc_new, fc_new = trunk_layer(
            xs, l, cache_k[l], cache_v[l], state_gdn[l], state_gdn_conv[l], state_ffn_conv[l], W)
        ksm.append(k_new); vsm.append(v_new); ssm.append(s_new); gcs.append(gc_new); fcs.append(fc_new)
    y_sample = rmsnorm(xs, final_norm_g)

    k_prompt = jnp.stack(kp)
    v_prompt = jnp.stack(vp)
    gdn_prompt = jnp.stack(sp)
    gdn_conv_prompt = jnp.stack(gcp)
    ffn_conv_prompt = jnp.stack(fcp)
    k_sample = jnp.stack(ksm)
    v_sample = jnp.stack(vsm)
    gdn_sample = jnp.stack(ssm)
    gdn_conv_sample = jnp.stack(gcs)
    ffn_conv_sample = jnp.stack(fcs)
    return (y_prompt, y_sample, k_prompt, v_prompt, gdn_prompt, gdn_conv_prompt, ffn_conv_prompt,
            k_sample, v_sample, gdn_sample, gdn_conv_sample, ffn_conv_sample)
```

```cpp
#include <hip/hip_runtime.h>
#include <hip/hip_cooperative_groups.h>
#include <cstdio>
#include <cstdint>
namespace cg = cooperative_groups;

#define LAS __attribute__((address_space(3)))
#define GAS __attribute__((address_space(1)))
typedef unsigned short bf16_t;
typedef short bf16x8 __attribute__((ext_vector_type(8)));
typedef short s16x4 __attribute__((ext_vector_type(4)));
typedef float f32x4 __attribute__((ext_vector_type(4)));
typedef float f32x16 __attribute__((ext_vector_type(16)));
typedef unsigned u32x4 __attribute__((ext_vector_type(4)));
typedef unsigned u32x2 __attribute__((ext_vector_type(2)));

#ifndef PROBE_SCAN
#define PROBE_SCAN 1
#endif
#ifndef PROBE_PREP
#define PROBE_PREP 1
#endif
#ifndef PROBE_MISC
#define PROBE_MISC 1
#endif
#ifndef PROBE_P2B
#define PROBE_P2B 1
#endif
constexpr int D = 1024, TP = 16384, NSROWS = 512, M = TP + NSROWS;
constexpr int PAST = 4096, KVS = PAST + 64;
constexpr int NIN = 9472;
constexpr int FF = 2816, FF2 = 5632;
constexpr float EPS = 1e-6f;
constexpr float QSCALE = 0.125f * 1.4426950408889634f;
constexpr float LOG2E = 1.4426950408889634f;

constexpr size_t O_YP = 0, O_KP = 17301504, O_VP = 50855936, O_GP = 84410368, O_GCP = 84672512, O_FCP = 84690944,
                 O_KS = 84713472, O_VS = 85762048, O_GS = 86810624, O_GCS = 88907776, O_FCS = 89055232;

constexpr size_t MiB = 1u << 20;
constexpr size_t WS_CTL = 0;
constexpr size_t CTL_SS = 65536;
constexpr size_t WS_W = 1 * MiB, W_LSTRIDE = 42 * MiB;
constexpr size_t WS_X = 86 * MiB, WS_XN = 152 * MiB;
constexpr size_t WS_KS = 185 * MiB, WS_VTS = 250 * MiB;
constexpr size_t WS_QA = 315 * MiB, WS_KP = 348 * MiB, WS_VTP = 380 * MiB;
constexpr size_t WS_MG = 315 * MiB, WS_MERGED = 381 * MiB;
constexpr size_t WS_QKVB = 414 * MiB, WS_Z = 513 * MiB, WS_GA = 546 * MiB, WS_GB = 579 * MiB, WS_BA = 612 * MiB;
constexpr size_t WS_U = 414 * MiB;
constexpr size_t WS_GDNP = 614 * MiB, WS_ACT = 614 * MiB;
constexpr size_t WS_OA = 798 * MiB, WS_OB = 831 * MiB;
constexpr size_t WS_SSP = 864 * MiB;
constexpr size_t BLOB = 91136;
constexpr int BLOB_A = 57344, BLOB_U = 57344, BLOB_EG = 90112;
constexpr int LDS_BYTES = 155648;

__device__ __forceinline__ unsigned f2bf(float f) { unsigned u = __builtin_bit_cast(unsigned, f); return (u + 0x7fffu + ((u >> 16) & 1u)) >> 16; }
typedef float f32x2_t __attribute__((ext_vector_type(2))); typedef __bf16 bf16x2_t __attribute__((ext_vector_type(2)));
__device__ __forceinline__ unsigned pk2(float lo, float hi) { f32x2_t v = {lo, hi}; bf16x2_t b = __builtin_convertvector(v, bf16x2_t); return __builtin_bit_cast(unsigned, b); }
__device__ __forceinline__ float bf2f(bf16_t b) { return __uint_as_float((unsigned)b << 16); }
__device__ __forceinline__ float bflo(unsigned w) { return __uint_as_float(w << 16); }
__device__ __forceinline__ float bfhi(unsigned w) { return __uint_as_float(w & 0xffff0000u); }
__device__ __forceinline__ float sigmoidf_(float x) { return __builtin_amdgcn_rcpf(1.f + __expf(-x)); }
__device__ __forceinline__ float siluf_(float x) { return x * __builtin_amdgcn_rcpf(1.f + __expf(-x)); }
__device__ __forceinline__ void st_bf8(bf16_t* p, f32x4 a, f32x4 b) { u32x4 w; w.x = pk2(a[0], a[1]); w.y = pk2(a[2], a[3]); w.z = pk2(b[0], b[1]); w.w = pk2(b[2], b[3]); *(u32x4*)p = w; }
__device__ __forceinline__ void st_f8(float* p, f32x4 a, f32x4 b) { *(f32x4*)p = a; *(f32x4*)(p + 4) = b; }
__device__ __forceinline__ bf16x8 pack8(float a0, float a1, float a2, float a3, float a4, float a5, float a6, float a7) {
    u32x4 w; w.x = pk2(a0, a1); w.y = pk2(a2, a3); w.z = pk2(a4, a5); w.w = pk2(a6, a7); return __builtin_bit_cast(bf16x8, w); }
__device__ __forceinline__ float wave_sum(float v) {
#pragma unroll
    for (int o = 1; o < 64; o <<= 1) v += __shfl_xor(v, o);
    return v;
}
__device__ __forceinline__ float ss16(const float* p) { const f32x4 a = *(const f32x4*)p, b = *(const f32x4*)(p + 4), c = *(const f32x4*)(p + 8), d = *(const f32x4*)(p + 12);
    return (((a[0] + a[1]) + (a[2] + a[3])) + ((b[0] + b[1]) + (b[2] + b[3]))) + (((c[0] + c[1]) + (c[2] + c[3])) + ((d[0] + d[1]) + (d[2] + d[3]))); }
__device__ __forceinline__ int fresh_tid(int wave_s) { unsigned m = ~0u; asm volatile("" : "+s"(m)); return wave_s * 64 + (int)__builtin_amdgcn_mbcnt_hi(m, __builtin_amdgcn_mbcnt_lo(m, 0u)); }
__device__ __forceinline__ int crow(int r, int hi) { return (r & 3) + 8 * (r >> 2) + 4 * hi; }

namespace pg8 {
constexpr int BM = 256, BK = 64, HALF = 128, HTB = HALF * BK * 2, STAGE_BYTES = 8 * HTB, NXCD = 8, WGM = 8;
__host__ __device__ __forceinline__ int lds_byte(int r, int c) { const int st = (r >> 4) * 2 + (c >> 5), rr = r & 15, cc = c & 31, ob = rr * 64 + cc * 2; return st * 1024 + (ob ^ (((ob >> 9) & 1) << 5)); }
__host__ __device__ __forceinline__ void stage_rc(int b, int& R, int& C) { const int st = b / 1024, sb = b % 1024, swz = sb ^ (((sb >> 9) & 1) << 5); R = (st >> 1) * 16 + swz / 64; C = (st & 1) * 32 + (swz % 64) / 2; }
__host__ __device__ __forceinline__ int perm32(int rho) { const int n = rho >> 4, i = rho & 15; return 8 * (i >> 2) + 4 * n + (i & 3); }
struct Unit { int pm, pn; };
struct Gemm { const bf16_t* A; const bf16_t* Bt; int M, N, K; };
struct StaticOrder {
    int nM, nN, nwg, G, c;
    __host__ __device__ void init(int M_, int N_, int G_, int c_) { nM = M_ / BM; nN = N_ / BM; nwg = nM * nN; G = G_; c = c_; }
    __host__ __device__ bool next(int i, Unit& u) const {
        const long L = (long)i * G + c; if (L >= nwg) return false;
        int wgid = (int)L; { const int q = nwg / NXCD, r = nwg % NXCD, xcd = wgid % NXCD, off = wgid / NXCD; wgid = (xcd < r ? xcd * (q + 1) : r * (q + 1) + (xcd - r) * q) + off; }
        const int nig = WGM * nN, gid = wgid / nig, fm = gid * WGM, gsz = (nM - fm) < WGM ? (nM - fm) : WGM;
        u.pm = fm + ((wgid % nig) % gsz); u.pn = (wgid % nig) / gsz; return true;
    }
};
template <class Epi, bool ALIGN_EPI, bool SP2>
__device__ __forceinline__ void gemm_phase(LAS unsigned char* lds, const Gemm g, const StaticOrder& S, const Epi& E, int wave_s) {
    const int tid = fresh_tid(wave_s);
    const int wid = wave_s, lane = tid & 63, wr = wid >> 2, wc = wid & 3, fr = lane & 15, fq = lane >> 4;
    const int K = g.K, nt = K / BK;
    unsigned voffA[2], voffB[2];
#pragma unroll
    for (int i = 0; i < 2; ++i) { int R, C; stage_rc(tid * 16 + i * 8192, R, C); const int Rb = Epi::PERM ? ((R & ~31) + perm32(R & 31)) : R;
        voffA[i] = (unsigned)(R * K + C) * 2u; voffB[i] = (unsigned)(Rb * K + C) * 2u; }
    const size_t kstep = (size_t)(BK * 2);
    const size_t hstep = (size_t)HALF * K * 2;
    const size_t tstep = 2 * hstep;
    const unsigned ldsw = (unsigned)wid * 1024u;
    const int aoff = lds_byte(wr * 64 + fr, fq * 8), boff = lds_byte(wc * 32 + fr, fq * 8);
#define PG8_SA(b, h) (((b) * 2 + (h)) * HTB)
#define PG8_SB(b, h) ((4 + (b) * 2 + (h)) * HTB)
#define PG8_STAGE(bufoff, gbase, voff) do { _Pragma("unroll") for (int _i = 0; _i < 2; ++_i) \
        __builtin_amdgcn_global_load_lds((const unsigned*)((const char*)(gbase) + (voff)[_i]), (LAS unsigned*)(lds + (bufoff) + ldsw + _i * 8192), 16, 0, 0); } while (0)
#define PG8_LDA(dst, b, h) do { _Pragma("unroll") for (int m = 0; m < 4; ++m) _Pragma("unroll") for (int k = 0; k < 2; ++k) dst[m][k] = *(const LAS bf16x8*)(lds + PG8_SA(b, h) + aoff + m * 2048 + k * 1024); } while (0)
#define PG8_LDB(dst, b, h) do { _Pragma("unroll") for (int n = 0; n < 2; ++n) _Pragma("unroll") for (int k = 0; k < 2; ++k) dst[n][k] = *(const LAS bf16x8*)(lds + PG8_SB(b, h) + boff + n * 2048 + k * 1024); } while (0)
#define PG8_MMA(ai, bj, At, Bt) do { __builtin_amdgcn_s_setprio(1); _Pragma("unroll") for (int m = 0; m < 4; ++m) _Pragma("unroll") for (int n = 0; n < 2; ++n) _Pragma("unroll") for (int k = 0; k < 2; ++k) \
        acc[ai][bj][m][n] = __builtin_amdgcn_mfma_f32_16x16x32_bf16(Bt[n][k], At[m][k], acc[ai][bj][m][n], 0, 0, 0); __builtin_amdgcn_s_setprio(0); } while (0)
#define PG8_WAIT_V(n) asm volatile("s_waitcnt vmcnt(" #n ")" ::: "memory")
#define PG8_WAIT_L(n) asm volatile("s_waitcnt lgkmcnt(" #n ")" ::: "memory")
#define PG8_BAR __builtin_amdgcn_s_barrier()
#define PG8_SCHED __builtin_amdgcn_sched_barrier(0)
    Unit cur, nxt; int ui = 0;
    if (!S.next(0, cur)) return;
    f32x4 acc[2][2][4][2];
#pragma unroll
    for (int a = 0; a < 2; ++a)
#pragma unroll
        for (int b = 0; b < 2; ++b)
#pragma unroll
            for (int m = 0; m < 4; ++m)
#pragma unroll
                for (int n = 0; n < 2; ++n) acc[a][b][m][n] = (f32x4){0.f, 0.f, 0.f, 0.f};
    bf16x8 At[4][2], B0[2][2], B1[2][2];
    const char* cA = (const char*)g.A + (size_t)cur.pm * tstep; const char* cB = (const char*)g.Bt + (size_t)cur.pn * tstep;
    if constexpr (SP2) {
        PG8_STAGE(PG8_SB(0, 0), cB, voffB); PG8_STAGE(PG8_SB(0, 1), cB + hstep, voffB); PG8_STAGE(PG8_SA(0, 0), cA, voffA); PG8_STAGE(PG8_SA(0, 1), cA + hstep, voffA);
        if (wr == 1) PG8_BAR;
        PG8_WAIT_V(2); PG8_BAR;
        PG8_STAGE(PG8_SB(1, 0), cB + kstep, voffB); PG8_STAGE(PG8_SA(1, 0), cA + kstep, voffA); PG8_STAGE(PG8_SB(1, 1), cB + hstep + kstep, voffB);
        PG8_WAIT_V(6); PG8_BAR;
    } else {
        PG8_STAGE(PG8_SB(0, 0), cB, voffB); PG8_STAGE(PG8_SA(0, 0), cA, voffA); PG8_STAGE(PG8_SB(0, 1), cB + hstep, voffB); PG8_STAGE(PG8_SA(0, 1), cA + hstep, voffA);
        if (wr == 1) PG8_BAR;
        PG8_WAIT_V(4); PG8_BAR;
        PG8_STAGE(PG8_SB(1, 0), cB + kstep, voffB); PG8_STAGE(PG8_SA(1, 0), cA + kstep, voffA); PG8_STAGE(PG8_SB(1, 1), cB + hstep + kstep, voffB);
        PG8_WAIT_V(6); PG8_BAR;
    }
    for (;;) {
        const bool has_next = S.next(ui + 1, nxt);
        const char* nA = has_next ? (const char*)g.A + (size_t)nxt.pm * tstep : cA; const char* nB = has_next ? (const char*)g.Bt + (size_t)nxt.pn * tstep : cB;
        for (int t = 0; t < nt; t += 2) {
            const bool last = (t == nt - 2);
            const char* a1 = cA + (size_t)(t + 1) * kstep;
            const char* a2 = last ? nA : cA + (size_t)(t + 2) * kstep; const char* b2 = last ? nB : cB + (size_t)(t + 2) * kstep;
            const char* a3 = a2 + kstep; const char* b3 = b2 + kstep;
            if constexpr (SP2) {
            PG8_LDB(B0, 0, 0); PG8_LDB(B1, 0, 1); PG8_SCHED; PG8_LDA(At, 0, 0); PG8_STAGE(PG8_SA(1, 1), a1 + hstep, voffA);
            PG8_WAIT_V(8); PG8_WAIT_L(0); PG8_BAR; PG8_MMA(0, 0, At, B0); PG8_MMA(0, 1, At, B1); PG8_BAR; PG8_SCHED;
            PG8_LDA(At, 0, 1); PG8_STAGE(PG8_SB(0, 0), b2, voffB); PG8_STAGE(PG8_SB(0, 1), b2 + hstep, voffB); PG8_STAGE(PG8_SA(0, 0), a2, voffA);
            PG8_WAIT_V(8); PG8_WAIT_L(0); PG8_BAR; PG8_MMA(1, 0, At, B0); PG8_MMA(1, 1, At, B1); PG8_BAR; PG8_SCHED;
            PG8_LDB(B0, 1, 0); PG8_LDB(B1, 1, 1); PG8_SCHED; PG8_LDA(At, 1, 0); PG8_STAGE(PG8_SA(0, 1), a2 + hstep, voffA);
            PG8_WAIT_V(8); PG8_WAIT_L(0); PG8_BAR; PG8_MMA(0, 0, At, B0); PG8_MMA(0, 1, At, B1); PG8_BAR; PG8_SCHED;
            PG8_LDA(At, 1, 1); PG8_STAGE(PG8_SB(1, 0), b3, voffB); PG8_STAGE(PG8_SB(1, 1), b3 + hstep, voffB); PG8_STAGE(PG8_SA(1, 0), a3, voffA);
            PG8_WAIT_V(8); PG8_WAIT_L(0); PG8_BAR; PG8_MMA(1, 0, At, B0); PG8_MMA(1, 1, At, B1); PG8_BAR; PG8_SCHED;
            } else {
            PG8_LDB(B0, 0, 0); PG8_SCHED; PG8_LDA(At, 0, 0); PG8_STAGE(PG8_SA(1, 1), a1 + hstep, voffA);
            PG8_WAIT_L(8); PG8_BAR; PG8_WAIT_L(0); PG8_MMA(0, 0, At, B0); PG8_BAR; PG8_SCHED;
            PG8_LDB(B1, 0, 1); PG8_STAGE(PG8_SB(0, 0), b2, voffB);
            PG8_BAR; PG8_WAIT_L(0); PG8_MMA(0, 1, At, B1); PG8_BAR;
            PG8_LDA(At, 0, 1); PG8_STAGE(PG8_SA(0, 0), a2, voffA);
            PG8_BAR; PG8_WAIT_L(0); PG8_MMA(1, 0, At, B0); PG8_BAR; PG8_SCHED;
            PG8_STAGE(PG8_SB(0, 1), b2 + hstep, voffB);
            PG8_WAIT_V(6); PG8_BAR; PG8_MMA(1, 1, At, B1); PG8_BAR;
            PG8_LDB(B0, 1, 0); PG8_SCHED; PG8_LDA(At, 1, 0); PG8_STAGE(PG8_SA(0, 1), a2 + hstep, voffA);
            PG8_WAIT_L(8); PG8_BAR; PG8_WAIT_L(0); PG8_MMA(0, 0, At, B0); PG8_BAR; PG8_SCHED;
            PG8_LDB(B1, 1, 1); PG8_STAGE(PG8_SB(1, 0), b3, voffB);
            PG8_BAR; PG8_WAIT_L(0); PG8_MMA(0, 1, At, B1); PG8_BAR;
            PG8_LDA(At, 1, 1); PG8_STAGE(PG8_SA(1, 0), a3, voffA);
            PG8_BAR; PG8_WAIT_L(0); PG8_MMA(1, 0, At, B0); PG8_BAR; PG8_SCHED;
            PG8_STAGE(PG8_SB(1, 1), b3 + hstep, voffB);
            PG8_WAIT_V(6); PG8_BAR; PG8_MMA(1, 1, At, B1); PG8_BAR;
            }
        }
        if constexpr (ALIGN_EPI) { if (wr == 0) PG8_BAR; }
        E(acc, cur, wr, wc, fr, fq);
        if (!has_next) break;
#pragma unroll
        for (int a = 0; a < 2; ++a)
#pragma unroll
            for (int b = 0; b < 2; ++b)
#pragma unroll
                for (int m = 0; m < 4; ++m)
#pragma unroll
                    for (int n = 0; n < 2; ++n) acc[a][b][m][n] = (f32x4){0.f, 0.f, 0.f, 0.f};
        cur = nxt; cA = nA; cB = nB; ++ui;
        if constexpr (ALIGN_EPI) { if (wr == 1) PG8_BAR; }
    }
    PG8_WAIT_V(0);
    if constexpr (!ALIGN_EPI) { if (wr == 0) PG8_BAR; }
    PG8_BAR;
#undef PG8_SA
#undef PG8_SB
#undef PG8_STAGE
#undef PG8_LDA
#undef PG8_LDB
#undef PG8_MMA
#undef PG8_WAIT_V
#undef PG8_WAIT_L
#undef PG8_BAR
#undef PG8_SCHED
}
}
using pg8::Unit;

#define EPI_ROWS_BEGIN _Pragma("unroll") for (int ai = 0; ai < 2; ++ai) _Pragma("unroll") for (int m = 0; m < 4; ++m) { const int row = u.pm * 256 + ai * 128 + wr * 64 + m * 16 + fr;
#define EPI_COLS_BEGIN _Pragma("unroll") for (int bj = 0; bj < 2; ++bj) { const int col = u.pn * 256 + bj * 128 + wc * 32 + 8 * fq; f32x4 v0 = acc[ai][bj][m][0], v1 = acc[ai][bj][m][1];
#define EPI_END } asm volatile("" ::: "memory"); }

struct EpiIn {
    static constexpr bool PERM = true;
    const float* ss; bf16_t *QA, *KP, *KS, *VTP, *VTS, *QKVB, *Z, *GA, *GB; float* BA;
    float *okp, *ovp, *oks, *ovs, *ogcp, *ogcs;
    __device__ __forceinline__ void operator()(const f32x4 (&acc)[2][2][4][2], const Unit& u, int wr, int wc, int fr, int fq) const {
        const int pn = u.pn;
        EPI_ROWS_BEGIN
            const float rs = rsqrtf(ss16(ss + (size_t)row * 16) * (1.f / 1024.f) + EPS);
            const bool samp = row >= TP; const int sidx = row - TP, sb = sidx >> 6, st = sidx & 63;
            EPI_COLS_BEGIN
                v0 = v0 * rs; v1 = v1 * rs;
                if (pn < 4) { st_bf8(QA + (size_t)row * 1024 + col, v0 * QSCALE, v1 * QSCALE); }
                else if (pn < 8) { const int c = col - 1024;
                    bf16_t* kb = samp ? KS + ((size_t)(sb * KVS + PAST + st)) * 1024 + c : KP + (size_t)row * 1024 + c; st_bf8(kb, v0, v1);
                    float* ko = samp ? oks + (size_t)sidx * 1024 + c : okp + (size_t)row * 1024 + c; st_f8(ko, v0, v1); }
                else if (pn < 12) { const int c = col - 2048;
                    float* vo = samp ? ovs + (size_t)sidx * 1024 + c : ovp + (size_t)row * 1024 + c; st_f8(vo, v0, v1);
                    bf16_t* vb = samp ? VTS + ((size_t)(sb * 1024 + c)) * KVS + PAST + st : VTP + (size_t)c * TP + row;
                    const size_t vp = samp ? (size_t)KVS : (size_t)TP;
#pragma unroll
                    for (int j = 0; j < 4; ++j) { vb[(size_t)j * vp] = (bf16_t)f2bf(v0[j]); vb[(size_t)(j + 4) * vp] = (bf16_t)f2bf(v1[j]); } }
                else if (pn < 24) { const int c = col - 3072; st_bf8(QKVB + (size_t)row * 3072 + c, v0, v1);
                    if (!samp && row >= TP - 3) st_f8(ogcp + (size_t)(row - (TP - 3)) * 3072 + c, v0, v1);
                    if (samp && st >= 61) st_f8(ogcs + (size_t)(sb * 3 + st - 61) * 3072 + c, v0, v1); }
                else if (pn < 28) { st_bf8(Z + (size_t)row * 1024 + (col - 6144), v0, v1); }
                else if (pn < 36) { bf16_t* gp = (pn < 32 ? GA + (col - 7168) : GB + (col - 8192)) + (size_t)row * 1024;
#pragma unroll
                    for (int j = 0; j < 4; ++j) { v0[j] = sigmoidf_(v0[j]); v1[j] = sigmoidf_(v1[j]); }
                    st_bf8(gp, v0, v1); }
                else { const int c = col - 9216; if (c < 16) st_f8(BA + (size_t)row * 16 + c, v0, v1); }
        EPI_END
    }
};
struct EpiGateA {
    static constexpr bool PERM = true;
    const bf16_t* G; float* MG;
    __device__ __forceinline__ void operator()(const f32x4 (&acc)[2][2][4][2], const Unit& u, int wr, int wc, int fr, int fq) const {
        EPI_ROWS_BEGIN EPI_COLS_BEGIN
            const size_t o = (size_t)row * 1024 + col; const u32x4 g = *(const u32x4*)(G + o);
            v0[0] *= bflo(g.x); v0[1] *= bfhi(g.x); v0[2] *= bflo(g.y); v0[3] *= bfhi(g.y); v1[0] *= bflo(g.z); v1[1] *= bfhi(g.z); v1[2] *= bflo(g.w); v1[3] *= bfhi(g.w);
            st_f8(MG + o, v0, v1);
        EPI_END
    }
};
struct EpiGateB {
    static constexpr bool PERM = true;
    const bf16_t* G; const float* MG; bf16_t* OUT;
    __device__ __forceinline__ void operator()(const f32x4 (&acc)[2][2][4][2], const Unit& u, int wr, int wc, int fr, int fq) const {
        EPI_ROWS_BEGIN EPI_COLS_BEGIN
            const size_t o = (size_t)row * 1024 + col; const u32x4 g = *(const u32x4*)(G + o);
            const f32x4 m0 = *(const f32x4*)(MG + o), m1 = *(const f32x4*)(MG + o + 4);
            v0[0] = m0[0] + v0[0] * bflo(g.x); v0[1] = m0[1] + v0[1] * bfhi(g.x); v0[2] = m0[2] + v0[2] * bflo(g.y); v0[3] = m0[3] + v0[3] * bfhi(g.y);
            v1[0] = m1[0] + v1[0] * bflo(g.z); v1[1] = m1[1] + v1[1] * bfhi(g.z); v1[2] = m1[2] + v1[2] * bflo(g.w); v1[3] = m1[3] + v1[3] * bfhi(g.w);
            st_bf8(OUT + o, v0, v1);
        EPI_END
    }
};
struct EpiRes {
    static constexpr bool PERM = true;
    float* X; const float* g; bf16_t* XN; float* ssout;
    __device__ __forceinline__ void operator()(const f32x4 (&acc)[2][2][4][2], const Unit& u, int wr, int wc, int fr, int fq) const {
        EPI_ROWS_BEGIN
            float s = 0.f;
            EPI_COLS_BEGIN
                const size_t o = (size_t)row * 1024 + col;
                v0 = v0 + *(const f32x4*)(X + o); v1 = v1 + *(const f32x4*)(X + o + 4);
                st_f8(X + o, v0, v1);
                s += (v0[0] * v0[0] + v0[1] * v0[1]) + (v0[2] * v0[2] + v0[3] * v0[3]) + (v1[0] * v1[0] + v1[1] * v1[1]) + (v1[2] * v1[2] + v1[3] * v1[3]);
                const f32x4 g0 = *(const f32x4*)(g + col), g1 = *(const f32x4*)(g + col + 4);
                st_bf8(XN + o, v0 * g0, v1 * g1);
            }
            s += __shfl_xor(s, 16); s += __shfl_xor(s, 32);
            if (fq == 0) ssout[(size_t)row * 16 + u.pn * 4 + wc] = s;
            asm volatile("" ::: "memory");
        }
    }
};
struct EpiUp {
    static constexpr bool PERM = true;
    const float* ss; bf16_t* U; float *ofcp, *ofcs;
    __device__ __forceinline__ void operator()(const f32x4 (&acc)[2][2][4][2], const Unit& u, int wr, int wc, int fr, int fq) const {
        EPI_ROWS_BEGIN
            const float rs = rsqrtf(ss16(ss + (size_t)row * 16) * (1.f / 1024.f) + EPS);
            const bool samp = row >= TP; const int sidx = row - TP, sb = sidx >> 6, st = sidx & 63;
            EPI_COLS_BEGIN
                v0 = v0 * rs; v1 = v1 * rs;
                st_bf8(U + (size_t)row * FF2 + col, v0, v1);
                if (!samp && row >= TP - 2) st_f8(ofcp + (size_t)(row - (TP - 2)) * FF2 + col, v0, v1);
                if (samp && st >= 62) st_f8(ofcs + (size_t)(sb * 2 + st - 62) * FF2 + col, v0, v1);
        EPI_END
    }
};

struct Params { const float* in[27]; float* out; unsigned char* ws; };

#define INP(i) (p.in[i])
__device__ __forceinline__ float uni(float v) { return __builtin_bit_cast(float, __builtin_amdgcn_readfirstlane(__builtin_bit_cast(int, v))); }
__device__ __forceinline__ void transpose_item(const float* src, size_t sp, bf16_t* dst, size_t dp, float* scr, int lane) {
#pragma unroll 8
    for (int i = 0; i < 32; ++i) { const int kk = 2 * i + (lane >> 5); scr[kk * 33 + (lane & 31)] = src[(size_t)kk * sp + (lane & 31)]; }
    __builtin_amdgcn_s_waitcnt(0); asm volatile("" ::: "memory");
    const int c = lane & 7;
#pragma unroll
    for (int j = 0; j < 4; ++j) { const int n = (lane >> 3) + 8 * j; const float* s = scr + (8 * c) * 33 + n;
        u32x4 o; o.x = pk2(s[0 * 33], s[1 * 33]); o.y = pk2(s[2 * 33], s[3 * 33]); o.z = pk2(s[4 * 33], s[5 * 33]); o.w = pk2(s[6 * 33], s[7 * 33]);
        *(u32x4*)(dst + (size_t)n * dp + 8 * c) = o; }
    __builtin_amdgcn_s_waitcnt(0); asm volatile("" ::: "memory");
}

constexpr int AT_SLOT = 16384, AT_Q = 4 * AT_SLOT, AT_QW = 32 * 272;
__device__ __forceinline__ void attn_unit(unsigned char* lds, const bf16_t* Qg, const bf16_t* Kg, const bf16_t* VTg, size_t vt_pitch, bf16_t* Og,
                                          int nactive, int qpos0, int ntiles, float sl2, const float* lamp, const float* subg, int wave_s, const unsigned* kmax2p) {
    const int tid = fresh_tid(wave_s);
    const int lane = tid & 63, wave = wave_s, q = lane & 31, hi = lane >> 5;
    const bool active = wave < nactive;
    const int qpos = qpos0 + 32 * wave + q;
    const int tv = active ? ((qpos0 + 32 * wave) >> 6) : -1;
    f32x16 O1[4], O2[4];
#pragma unroll
    for (int nb = 0; nb < 4; ++nb) { O1[nb] = (f32x16){}; O2[nb] = (f32x16){}; }
    float m1 = 0.f, m2 = 0.f, l1 = 0.f, l2 = 0.f;
    unsigned koff, voff;
    { const int kr = 4 * wave + (lane >> 4), kc = (lane & 15) ^ (kr & 15); koff = (unsigned)(kr * 1024 + kc * 8);
      const int vr = 16 * wave + (lane >> 2), vcx = (lane & 3) ^ ((vr >> 2) & 3); voff = (unsigned)(vr * (int)vt_pitch + vcx * 8); }
    LAS unsigned char* lds3 = (LAS unsigned char*)lds;
    const int nhalf = 2 * ntiles;
#define AT_DMA(u_) do { const int uu_ = (u_) < nhalf ? nhalf - 1 - (u_) : 0; const int sl_ = (u_) & 3; \
        __builtin_amdgcn_global_load_lds((const unsigned*)(Kg + (size_t)(koff + 32768u * (unsigned)uu_)), (LAS unsigned*)(lds3 + sl_ * AT_SLOT + wave * 1024), 16, 0, 0); \
        __builtin_amdgcn_global_load_lds((const unsigned*)(VTg + (size_t)(voff + 32u * (unsigned)uu_)), (LAS unsigned*)(lds3 + sl_ * AT_SLOT + 8192 + wave * 1024), 16, 0, 0); } while (0)
    unsigned char* Qs = lds + AT_Q + wave * AT_QW;
    const int lpk0 = (((q & 15) ^ hi) * 16) + q * 256, lpv0 = q * 64 + ((q >> 2) & 3) * 16 + 8 * hi;
    const int qaddr = AT_Q + wave * AT_QW + q * 272 + hi * 16, qd = qpos - 4 * hi;
    __syncthreads();
    {
        if (active) {
#pragma unroll
            for (int k = 0; k < 8; ++k) { const int pc = lane + 64 * k, r = pc >> 4, ch = pc & 15; *(u32x4*)(Qs + r * 272 + ch * 16) = *(const u32x4*)(Qg + (size_t)(32 * wave + r) * 1024 + ch * 8); }
        }
        asm volatile("s_waitcnt vmcnt(0) lgkmcnt(0)" ::: "memory");
        AT_DMA(0); AT_DMA(1); AT_DMA(2);
    }
    float bq1 = 0.f, bq2 = 0.f;
    if (kmax2p && active) { float s1 = 0.f, s2 = 0.f;
#pragma unroll
        for (int ch = 0; ch < 16; ++ch) { const u32x4 w = *(const u32x4*)(lds + (qaddr - hi * 16) + ch * 16);
            const float a0 = bflo(w.x), a1 = bfhi(w.x), a2 = bflo(w.y), a3 = bfhi(w.y), a4 = bflo(w.z), a5 = bfhi(w.z), a6 = bflo(w.w), a7 = bfhi(w.w);
            const float ss = (a0 * a0 + a1 * a1) + (a2 * a2 + a3 * a3) + (a4 * a4 + a5 * a5) + (a6 * a6 + a7 * a7);
            if (ch < 8) s1 += ss; else s2 += ss; }
        bq1 = sqrtf(s1) * sqrtf(__uint_as_float(kmax2p[0])) * 1.01f + 1.f; bq2 = sqrtf(s2) * sqrtf(__uint_as_float(kmax2p[1])) * 1.01f + 1.f; }
    unsigned char* flg = lds + AT_Q + 8 * AT_QW;
    for (int v = 0; v < nhalf; ++v) { const int u = nhalf - 1 - v;
        asm volatile("s_waitcnt vmcnt(4) lgkmcnt(0)\n\ts_barrier" ::: "memory");
        if (kmax2p && v > 0) { const u32x2 fv = *(const u32x2*)(flg + ((v - 1) & 1) * 8);
            const unsigned fw = fv.x & fv.y;
            if (__builtin_amdgcn_readfirstlane(fw & (fw >> 8) & (fw >> 16) & (fw >> 24) & 1u)) break; }
        AT_DMA(v + 3);
        const unsigned char* Ks = lds + (v & 3) * AT_SLOT; const unsigned char* Vs = Ks + 8192;
        const int t = u >> 1;
        if (t <= tv) {
            int lpk = lpk0, lpv = lpv0; asm volatile("" : "+v"(lpk), "+v"(lpv));
            const unsigned char* Kl = Ks; const unsigned char* Vl = Vs;
            const bool diag = (t == tv);
            {
                const float dfl = (float)(32 * u - qd);
                bf16x8 PA[2], PB[2];
#pragma unroll
                for (int mp = 0; mp < 2; ++mp) {
                    f32x16 p0 = (f32x16){};
#pragma unroll
                    for (int ds = 0; ds < 4; ++ds) {
                        const bf16x8 qf = *(const bf16x8*)(lds + qaddr + (mp * 64 + ds * 16) * 2);
                        const bf16x8 a0 = *(const bf16x8*)(Kl + (lpk ^ ((mp * 8 + ds * 2) * 16)));
                        p0 = __builtin_amdgcn_mfma_f32_32x32x16_bf16(a0, qf, p0, 0, 0, 0);
                    }
                    const float mo = mp ? m2 : m1;
                    if (!diag) { const float cm = sl2 * dfl - mo;
#pragma unroll
                        for (int r = 0; r < 16; ++r) p0[r] = fmaf(sl2, (float)((r & 3) + 8 * (r >> 2)), p0[r]) + cm;
                    } else {
#pragma unroll
                        for (int r = 0; r < 16; ++r) p0[r] = p0[r] - sl2 * fabsf(dfl + (float)((r & 3) + 8 * (r >> 2))) - mo;
                    }
                    float mx = fmaxf(fmaxf(p0[0], p0[1]), p0[2]);
#pragma unroll
                    for (int r = 3; r < 15; r += 2) mx = fmaxf(fmaxf(mx, p0[r]), p0[r + 1]);
                    mx = fmaxf(mx, p0[15]);
                    { auto rr = __builtin_amdgcn_permlane32_swap(__float_as_uint(mx), __float_as_uint(mx), false, false); mx = fmaxf(__uint_as_float(rr[0]), __uint_as_float(rr[1])); }
                    const bool first = (u == 2 * tv + 1);
                    if (first || __any(mx > 8.f)) {
                        const float dl = first ? mx : fmaxf(mx, 0.f);
#pragma unroll
                        for (int r = 0; r < 16; ++r) p0[r] -= dl;
                        if (!first) { const float al = __builtin_amdgcn_exp2f(-dl);
                            if (mp == 0) { l1 *= al;
#pragma unroll
                                for (int nb = 0; nb < 4; ++nb) O1[nb] = O1[nb] * al; }
                            else { l2 *= al;
#pragma unroll
                                for (int nb = 0; nb < 4; ++nb) O2[nb] = O2[nb] * al; } }
                        if (mp == 0) m1 = mo + dl; else m2 = mo + dl;
                    }
                    float rsum = 0.f;
#pragma unroll
                    for (int r = 0; r < 16; ++r) { p0[r] = __builtin_amdgcn_exp2f(p0[r]); rsum += p0[r]; }
                    if (mp == 0) { l1 += rsum; PA[0] = pack8(p0[0], p0[1], p0[2], p0[3], p0[4], p0[5], p0[6], p0[7]); PA[1] = pack8(p0[8], p0[9], p0[10], p0[11], p0[12], p0[13], p0[14], p0[15]); }
                    else { l2 += rsum; PB[0] = pack8(p0[0], p0[1], p0[2], p0[3], p0[4], p0[5], p0[6], p0[7]); PB[1] = pack8(p0[8], p0[9], p0[10], p0[11], p0[12], p0[13], p0[14], p0[15]); }
                }
#pragma unroll
                for (int nb = 0; nb < 4; ++nb) {
#pragma unroll
                    for (int jj = 0; jj < 2; ++jj) { const unsigned char* vp = Vl + nb * 2048;
                        const s16x4 lo = *(const s16x4*)(vp + (lpv ^ ((2 * jj) * 16))), hh = *(const s16x4*)(vp + (lpv ^ ((2 * jj + 1) * 16)));
                        const bf16x8 vf = (bf16x8){lo[0], lo[1], lo[2], lo[3], hh[0], hh[1], hh[2], hh[3]};
                        O1[nb] = __builtin_amdgcn_mfma_f32_32x32x16_bf16(vf, PA[jj], O1[nb], 0, 0, 0);
                        O2[nb] = __builtin_amdgcn_mfma_f32_32x32x16_bf16(vf, PB[jj], O2[nb], 0, 0, 0); }
                    asm volatile("" : "+v"(O1[nb]), "+v"(O2[nb])); __builtin_amdgcn_sched_barrier(0); }
                asm volatile("" ::: "memory");
            }
        }
        if (kmax2p) {
            bool negl = true;
            if (active) { const float dist = (float)(qd + 4 * hi - 32 * u + 1);
                negl = (u <= 2 * tv + 1) && (dist > 0.f) && (bq1 - sl2 * dist - m1 < -48.f) && (bq2 - sl2 * dist - m2 < -48.f); }
            const bool wv = __all(negl);
            if (lane == 0) flg[(v & 1) * 8 + wave] = wv ? 1 : 0;
        }
    }
#undef AT_DMA
    if (active) {
        const int tid2 = fresh_tid(wave_s);
        const int q = tid2 & 31, hi = (tid2 >> 5) & 1;
        l1 += __shfl_xor(l1, 32); l2 += __shfl_xor(l2, 32);
        const float lam = lamp[0], oscale = lamp[1];
        const float i1 = 1.f / l1, i2 = lam / l2; float ssq = 0.f;
#pragma unroll
        for (int nb = 0; nb < 4; ++nb)
#pragma unroll
            for (int r = 0; r < 16; ++r) { const float od = O1[nb][r] * i1 - O2[nb][r] * i2; O1[nb][r] = od; ssq += od * od; }
        ssq += __shfl_xor(ssq, 32);
        const float rn = rsqrtf(ssq * (1.f / 128.f) + EPS) * oscale;
        bf16_t* orow = Og + (size_t)(32 * wave + q) * 1024;
#pragma unroll
        for (int nb = 0; nb < 4; ++nb)
#pragma unroll
            for (int rg = 0; rg < 4; ++rg) { const int dv0 = 32 * nb + 8 * rg + 4 * hi; const f32x4 g = *(const f32x4*)(subg + dv0);
                u32x2 w; w.x = pk2(O1[nb][4 * rg] * rn * g[0], O1[nb][4 * rg + 1] * rn * g[1]); w.y = pk2(O1[nb][4 * rg + 2] * rn * g[2], O1[nb][4 * rg + 3] * rn * g[3]);
                *(u32x2*)(orow + dv0) = w; }
    }
    __syncthreads();
}

__device__ __forceinline__ void cache_conv_unit(unsigned char* lds, const Params& p, unsigned char* ws, int l, int b, int kvb, int wave_s) {
    const int tid = fresh_tid(wave_s); const int lane = tid & 63, wave = wave_s;
    const float* ck = p.in[2] + ((size_t)(l * 8 + b) * PAST + 64 * kvb) * 1024; const float* cv = p.in[3] + ((size_t)(l * 8 + b) * PAST + 64 * kvb) * 1024;
    bf16_t* KS = (bf16_t*)(ws + WS_KS) + ((size_t)b * KVS + 64 * kvb) * 1024; bf16_t* VTS = (bf16_t*)(ws + WS_VTS);
    __syncthreads();
#pragma unroll 4
    for (int k = 0; k < 16; ++k) { const size_t e = ((size_t)k * 512 + tid) * 8; const f32x4 a = *(const f32x4*)(ck + e), c4 = *(const f32x4*)(ck + e + 4); st_bf8(KS + e, a, c4); }
    float* scr = (float*)(lds + wave * 8448);
#pragma unroll 1
    for (int j = 0; j < 4; ++j) { const int it = wave * 4 + j, dvb = it & 3, hh = it >> 2;
        transpose_item(cv + hh * 128 + 32 * dvb, 1024, VTS + ((size_t)((b * 8 + hh) * 128 + 32 * dvb)) * KVS + 64 * kvb, KVS, scr, lane); }
    asm volatile("s_waitcnt vmcnt(0)" ::: "memory");
    __syncthreads();
    if (tid == 0) { __builtin_amdgcn_fence(__ATOMIC_RELEASE, "agent");
        __hip_atomic_fetch_add((unsigned*)(ws + WS_CTL) + 48 + l * 8 + b, 1u, __ATOMIC_RELAXED, __HIP_MEMORY_SCOPE_AGENT); }
}

constexpr int GP_LM = 0, GP_AT = 64 * 64 * 4, GP_SM = GP_AT + 64 * 65 * 4, GP_QC = GP_SM + 1024, GP_KC = GP_QC + 64 * 129 * 4, GP_VC = GP_KC + 64 * 129 * 4;
__device__ __forceinline__ void gdn_prep_unit(unsigned char* lds, const Params& p, int l, int ch, int h, int wave_s) {
    const int tid = fresh_tid(wave_s);
    const int lane = tid & 63, wave = wave_s;
    float* qc = (float*)(lds + GP_QC); float* kc = (float*)(lds + GP_KC); float* vc = (float*)(lds + GP_VC); float* Lm = (float*)(lds + GP_LM); float* AT = (float*)(lds + GP_AT);
    float* sG = (float*)(lds + GP_SM); float* sB = sG + 64; float* sRq = sG + 128; float* sRk = sG + 192;
    const bf16_t* QKVB = (const bf16_t*)(p.ws + WS_QKVB); const float* BA = (const float*)(p.ws + WS_BA);
    unsigned char* blob = p.ws + WS_GDNP + (size_t)(h * 264 + ch) * BLOB;
    const int m0 = ch * 64; const bool samp = ch >= 256; const int sb = ch - 256;
    __syncthreads();
    if (tid < 384) {
        const int part = tid >> 7, c = tid & 127;
        const int col = (part == 0 ? 2048 : (part == 1 ? 1024 : 0)) + h * 128 + c;
        float* dstc = (part == 0 ? vc : (part == 1 ? kc : qc)) + c;
        const float* cw = INP(14) + (size_t)l * 4 * 3072 + col;
        const float w0 = cw[0], w1 = cw[3072], w2 = cw[2 * 3072], w3 = cw[3 * 3072];
        float x3, x2, x1;
        if (samp) { const float* sc = INP(5) + ((size_t)(l * 8 + sb) * 3) * 3072 + col; x3 = sc[0]; x2 = sc[3072]; x1 = sc[2 * 3072]; }
        else if (ch == 0) { x3 = 0.f; x2 = 0.f; x1 = 0.f; }
        else { const bf16_t* pr = QKVB + (size_t)(m0 - 3) * 3072 + col; x3 = bf2f(pr[0]); x2 = bf2f(pr[3072]); x1 = bf2f(pr[2 * 3072]); }
        const bf16_t* xp = QKVB + (size_t)m0 * 3072 + col;
        bf16_t raw[64];
#pragma unroll
        for (int i = 0; i < 64; ++i) raw[i] = xp[(size_t)i * 3072];
#pragma unroll
        for (int i = 0; i < 64; ++i) {
            const float x0 = bf2f(raw[i]);
            float y = w0 * x3 + w1 * x2 + w2 * x1 + w3 * x0; y = siluf_(y);
            x3 = x2; x2 = x1; x1 = x0;
            dstc[i * 129] = y;
        }
    } else if (tid < 448) {
        const int i = tid - 384;
        const float braw = BA[(size_t)(m0 + i) * 16 + h], araw = BA[(size_t)(m0 + i) * 16 + 8 + h];
        const float xx = araw + INP(16)[l * 8 + h];
        const float sp = xx > 20.f ? xx : log1pf(__expf(xx));
        float G = -__expf(INP(15)[l * 8 + h]) * sp;
#pragma unroll
        for (int o = 1; o < 64; o <<= 1) { const float tt = __shfl_up(G, o); if (i >= o) G += tt; }
        sG[i] = G; sB[i] = sigmoidf_(braw);
    }
    __syncthreads();
    {
#pragma unroll
        for (int rr = 0; rr < 8; ++rr) { const int row = wave * 8 + rr;
            const float a = qc[row * 129 + lane], b = qc[row * 129 + 64 + lane], c2 = kc[row * 129 + lane], d2 = kc[row * 129 + 64 + lane];
            const float sq = wave_sum(a * a + b * b), sk = wave_sum(c2 * c2 + d2 * d2);
            if (lane == 0) { sRq[row] = rsqrtf(sq + EPS) * 0.08838834764831845f; sRk[row] = rsqrtf(sk + EPS); } }
    }
    __syncthreads();
    {
        const int fi = lane & 15, fk = lane >> 4;
#pragma unroll 1
        for (int tt = 0; tt < 4; ++tt) {
            const int tile = wave * 4 + tt, isq = tile >> 4, ti = (tile >> 2) & 3, tj = tile & 3;
            if (ti < tj) continue;
            const float* X = isq ? qc : kc;
            f32x4 d = (f32x4){0.f, 0.f, 0.f, 0.f};
#pragma unroll 8
            for (int s = 0; s < 32; ++s) {
                const float a = X[(16 * ti + fi) * 129 + 4 * s + fk], b = kc[(16 * tj + fi) * 129 + 4 * s + fk];
                d = __builtin_amdgcn_mfma_f32_16x16x4f32(a, b, d, 0, 0, 0);
            }
            const int j = 16 * tj + fi; const float gj = sG[j], rkj = sRk[j];
#pragma unroll
            for (int r = 0; r < 4; ++r) { const int i = 16 * ti + 4 * fk + r; const float gi = sG[i];
                const float dec = __expf(fminf(gi - gj, 0.f));
                if (isq) AT[i * 65 + j] = (i >= j) ? sRq[i] * rkj * d[r] * dec : 0.f;
                else Lm[i * 64 + j] = (i > j) ? sB[i] * sRk[i] * rkj * d[r] * dec : 0.f; }
        }
        for (int e = tid; e < 64 * 64; e += 512) { const int i = e >> 6, j = e & 63; if ((i >> 4) < (j >> 4)) { Lm[i * 64 + j] = 0.f; AT[i * 65 + j] = 0.f; } }
    }
    __syncthreads();
    const float glast = sG[63];
    if (tid < 256) {
        float xr[64];
        if (tid < 128) {
#pragma unroll
            for (int i = 0; i < 64; ++i) xr[i] = vc[i * 129 + tid] * sB[i];
        } else {
#pragma unroll
            for (int i = 0; i < 64; ++i) xr[i] = kc[i * 129 + tid - 128] * sB[i] * sRk[i] * __expf(sG[i]);
        }
#pragma unroll
        for (int i = 1; i < 64; ++i) {
            float a0 = 0.f, a1 = 0.f, a2 = 0.f, a3 = 0.f;
#pragma unroll
            for (int j4 = 0; j4 < (i + 3) / 4; ++j4) { const f32x4 lv = *(const f32x4*)(Lm + i * 64 + 4 * j4);
                a0 += lv[0] * xr[4 * j4]; if (4 * j4 + 1 < i) a1 += lv[1] * xr[4 * j4 + 1]; if (4 * j4 + 2 < i) a2 += lv[2] * xr[4 * j4 + 2]; if (4 * j4 + 3 < i) a3 += lv[3] * xr[4 * j4 + 3]; }
            xr[i] -= (a0 + a1) + (a2 + a3);
        }
        if (tid < 128) {
            const int v = tid, w = v >> 5, n = v & 31; float* U = (float*)(blob + BLOB_U);
#pragma unroll
            for (int tile = 0; tile < 2; ++tile)
#pragma unroll
                for (int a8 = 0; a8 < 4; ++a8)
#pragma unroll
                    for (int hh = 0; hh < 2; ++hh) { const int c0 = 32 * tile + 8 * a8 + 4 * hh;
                        *(f32x4*)(U + ((size_t)((w * 2 + tile) * 64 + hh * 32 + n)) * 16 + 4 * a8) = (f32x4){xr[c0], xr[c0 + 1], xr[c0 + 2], xr[c0 + 3]}; }
        } else {
            const int k = tid - 128, s = k >> 4, kk = k & 15, hh = (kk >> 2) & 1, j = (kk & 3) + 4 * (kk >> 3); bf16_t* W = (bf16_t*)blob;
#pragma unroll
            for (int c = 0; c < 64; ++c) { const int i = c >> 5, mrow = c & 31; W[(size_t)(((i * 8 + s) * 64 + hh * 32 + mrow)) * 8 + j] = (bf16_t)f2bf(-xr[c]); }
        }
    } else {
        const int t2 = tid - 256;
#pragma unroll 1
        for (int pc = t2; pc < 1024; pc += 256) { const int f = pc >> 6, ll = pc & 63, i = f >> 3, s = f & 7, row = 32 * i + (ll & 31), hh = ll >> 5;
            const float sc = sRq[row] * __expf(sG[row]); float vv[8];
#pragma unroll
            for (int j = 0; j < 8; ++j) vv[j] = qc[row * 129 + 16 * s + (j & 3) + 8 * (j >> 2) + 4 * hh] * sc;
            *(bf16x8*)(blob + 16384 + (size_t)pc * 16) = pack8(vv[0], vv[1], vv[2], vv[3], vv[4], vv[5], vv[6], vv[7]); }
#pragma unroll 1
        for (int pc = t2; pc < 512; pc += 256) { const int f = pc >> 6, ll = pc & 63, i = f >> 2, s = f & 3, row = 32 * i + (ll & 31), hh = ll >> 5; float vv[8];
#pragma unroll
            for (int j = 0; j < 8; ++j) vv[j] = AT[row * 65 + 16 * s + (j & 3) + 8 * (j >> 2) + 4 * hh];
            *(bf16x8*)(blob + 32768 + (size_t)pc * 16) = pack8(vv[0], vv[1], vv[2], vv[3], vv[4], vv[5], vv[6], vv[7]); }
#pragma unroll 1
        for (int pc = t2; pc < 1024; pc += 256) { const int f = pc >> 6, ll = pc & 63, kt = f >> 2, s = f & 3, krow = 32 * kt + (ll & 31), hh = ll >> 5; float vv[8];
#pragma unroll
            for (int j = 0; j < 8; ++j) { const int c = 16 * s + (j & 3) + 8 * (j >> 2) + 4 * hh; vv[j] = kc[c * 129 + krow] * sRk[c] * __expf(glast - sG[c]); }
            *(bf16x8*)(blob + 40960 + (size_t)pc * 16) = pack8(vv[0], vv[1], vv[2], vv[3], vv[4], vv[5], vv[6], vv[7]); }
        if (t2 == 0) *(float*)(blob + BLOB_EG) = __expf(glast);
    }
    asm volatile("s_waitcnt vmcnt(0)" ::: "memory");
    __syncthreads();
    if (tid == 0) { __builtin_amdgcn_fence(__ATOMIC_RELEASE, "agent");
        __hip_atomic_store((unsigned*)(p.ws + WS_CTL) + 8192 + l * 2112 + h * 264 + ch, 1u, __ATOMIC_RELAXED, __HIP_MEMORY_SCOPE_AGENT); }
}

constexpr int SC_OT = 2 * BLOB_A;
__device__ __forceinline__ void gdn_scan_unit(unsigned char* lds, unsigned char* ws, const float* gn, int ch0, int nsteps, int h, const float* S0, float* Sout, int wave_s, unsigned* rdy) {
    const int tid = fresh_tid(wave_s);
    const int lane = tid & 63, wave = wave_s, n = lane & 31, hi = lane >> 5;
    const unsigned char* blob0 = ws + WS_GDNP + (size_t)(h * 264 + ch0) * BLOB;
    const size_t bstep = (size_t)BLOB;
    float* ot = (float*)(lds + SC_OT);
    const bf16_t* Z = (const bf16_t*)(ws + WS_Z); bf16_t* OB = (bf16_t*)(ws + WS_OB);
#define SC_WAITRDY(a_, b_) do { if (tid == 0) { for (int k_ = (a_); k_ < (b_); ++k_) { unsigned sp_ = 0; \
            while (__hip_atomic_load(rdy + k_, __ATOMIC_RELAXED, __HIP_MEMORY_SCOPE_AGENT) == 0u) { __builtin_amdgcn_s_sleep(8); if (++sp_ > (1u << 24)) break; } } } \
        asm volatile("s_waitcnt vmcnt(0) lgkmcnt(0)" ::: "memory"); __builtin_amdgcn_s_barrier(); asm volatile("" ::: "memory"); \
        __builtin_amdgcn_fence(__ATOMIC_ACQUIRE, "agent"); } while (0)
    __syncthreads();
    SC_WAITRDY(0, nsteps < 32 ? nsteps : 32);
    LAS unsigned char* lds3 = (LAS unsigned char*)lds;
#define SC_DMA(src_, stage_) do { _Pragma("unroll") for (int k_ = 0; k_ < 14; ++k_) \
        __builtin_amdgcn_global_load_lds((const unsigned*)((src_) + (size_t)(((wave - 4) * 14 + k_) * 1024) + (unsigned)(lane * 16)), \
            (LAS unsigned*)(lds3 + (stage_) * BLOB_A + ((wave - 4) * 14 + k_) * 1024), 16, 0, 0); } while (0)
#define SC_BS(s) pack8(S[(s) >> 1][8 * ((s) & 1)], S[(s) >> 1][8 * ((s) & 1) + 1], S[(s) >> 1][8 * ((s) & 1) + 2], S[(s) >> 1][8 * ((s) & 1) + 3], S[(s) >> 1][8 * ((s) & 1) + 4], S[(s) >> 1][8 * ((s) & 1) + 5], S[(s) >> 1][8 * ((s) & 1) + 6], S[(s) >> 1][8 * ((s) & 1) + 7])
#define SC_NORM(cc, zz) do { const size_t mb_ = ((size_t)(ch0 + (cc)) * 64) * 1024 + h * 128; \
        float ssq_ = 0.f; \
        _Pragma("unroll") for (int k = 0; k < 8; ++k) { const f32x4 t4 = *(const f32x4*)(ot + nrow * 132 + 32 * nqd + 4 * k); ssq_ += (t4[0] * t4[0] + t4[1] * t4[1]) + (t4[2] * t4[2] + t4[3] * t4[3]); } \
        ssq_ += __shfl_xor(ssq_, 1); ssq_ += __shfl_xor(ssq_, 2); \
        const float rstd = rsqrtf(ssq_ * (1.f / 128.f) + EPS); bf16_t* op = OB + mb_ + nmoff; \
        _Pragma("unroll") for (int k = 0; k < 4; ++k) { const float* gg = gq + 8 * k; \
            const f32x4 oa = *(const f32x4*)(ot + nrow * 132 + 32 * nqd + 8 * k), ob = *(const f32x4*)(ot + nrow * 132 + 32 * nqd + 8 * k + 4); \
            u32x4 w; w.x = pk2(oa[0] * rstd * gg[0] * siluf_(bflo(zz[k].x)), oa[1] * rstd * gg[1] * siluf_(bfhi(zz[k].x))); \
            w.y = pk2(oa[2] * rstd * gg[2] * siluf_(bflo(zz[k].y)), oa[3] * rstd * gg[3] * siluf_(bfhi(zz[k].y))); \
            w.z = pk2(ob[0] * rstd * gg[4] * siluf_(bflo(zz[k].z)), ob[1] * rstd * gg[5] * siluf_(bfhi(zz[k].z))); \
            w.w = pk2(ob[2] * rstd * gg[6] * siluf_(bflo(zz[k].w)), ob[3] * rstd * gg[7] * siluf_(bfhi(zz[k].w))); \
            *(GAS u32x4*)(op + 8 * k) = w; } } while (0)
    if (wave < 4) {
        f32x16 S[4], Ua[2]; float ega = 0.f;
#pragma unroll
        for (int kt = 0; kt < 4; ++kt)
#pragma unroll
            for (int r = 0; r < 16; ++r) S[kt][r] = S0 ? S0[(size_t)(32 * kt + crow(r, hi)) * 128 + 32 * wave + n] : 0.f;
#define SC_ULD(UR, EG, cc) do { const unsigned char* ub_ = blob0 + (size_t)(cc) * bstep; \
            _Pragma("unroll") for (int i = 0; i < 2; ++i) UR[i] = *(const GAS f32x16*)(ub_ + (size_t)(BLOB_U + (wave * 2 + i) * 4096) + (unsigned)(lane * 64)); \
            EG = *(const GAS float*)(ub_ + BLOB_EG); } while (0)
#define SC_LDP12(F, s_) do { F[0] = *(const bf16x8*)(Al + ((s_)) * 1024); F[1] = *(const bf16x8*)(Al + (8 + (s_)) * 1024); F[2] = *(const bf16x8*)(Al + 16384 + ((s_)) * 1024); F[3] = *(const bf16x8*)(Al + 16384 + (8 + (s_)) * 1024); } while (0)
#define SC_LDROW(F, base_, f0_) do { _Pragma("unroll") for (int j_ = 0; j_ < 4; ++j_) F[j_] = *(const bf16x8*)(Al + (base_) + ((f0_) + j_) * 1024); } while (0)
#define SC_G12(s_, CUR, NXT, LOADNEXT) do { LOADNEXT; __builtin_amdgcn_sched_barrier(0); { const bf16x8 bs = SC_BS(s_); \
            vn[0] = __builtin_amdgcn_mfma_f32_32x32x16_bf16(CUR[0], bs, vn[0], 0, 0, 0); vn[1] = __builtin_amdgcn_mfma_f32_32x32x16_bf16(CUR[1], bs, vn[1], 0, 0, 0); \
            o[0] = __builtin_amdgcn_mfma_f32_32x32x16_bf16(CUR[2], bs, o[0], 0, 0, 0); o[1] = __builtin_amdgcn_mfma_f32_32x32x16_bf16(CUR[3], bs, o[1], 0, 0, 0); } \
            asm volatile("" : "+v"(vn[0]), "+v"(vn[1]), "+v"(o[0]), "+v"(o[1])); __builtin_amdgcn_sched_barrier(0); } while (0)
#define SC_GROW(ACC, CUR, NXT, LOADNEXT) do { LOADNEXT; __builtin_amdgcn_sched_barrier(0); \
            _Pragma("unroll") for (int j_ = 0; j_ < 4; ++j_) ACC = __builtin_amdgcn_mfma_f32_32x32x16_bf16(CUR[j_], bV[j_], ACC, 0, 0, 0); \
            asm volatile("" : "+v"(ACC)); __builtin_amdgcn_sched_barrier(0); } while (0)
#define SC_CSTEP(c, UR, EG) do { \
            const unsigned char* A = lds + ((c) & 1) * BLOB_A; \
            const float eg = EG; \
            f32x16 vn[2]; vn[0] = UR[0]; vn[1] = UR[1]; \
            if ((c) + 1 < nsteps) SC_ULD(UR, EG, (c) + 1); \
              \
            const unsigned char* Al = A + lane * 16; \
            bf16x8 F0[4], F1[4]; f32x16 o[2]; o[0] = (f32x16){}; o[1] = (f32x16){}; \
            SC_LDP12(F0, 0); \
            SC_G12(0, F0, F1, SC_LDP12(F1, 1)); SC_G12(1, F1, F0, SC_LDP12(F0, 2)); SC_G12(2, F0, F1, SC_LDP12(F1, 3)); SC_G12(3, F1, F0, SC_LDP12(F0, 4)); \
            SC_G12(4, F0, F1, SC_LDP12(F1, 5)); SC_G12(5, F1, F0, SC_LDP12(F0, 6)); SC_G12(6, F0, F1, SC_LDP12(F1, 7)); SC_G12(7, F1, F0, SC_LDROW(F0, 32768, 0)); \
            bf16x8 bV[4]; \
            _Pragma("unroll") for (int s = 0; s < 4; ++s) { const int i = s >> 1, b = 8 * (s & 1); \
                bV[s] = pack8(vn[i][b], vn[i][b + 1], vn[i][b + 2], vn[i][b + 3], vn[i][b + 4], vn[i][b + 5], vn[i][b + 6], vn[i][b + 7]); } \
            SC_GROW(o[0], F0, F1, SC_LDROW(F1, 32768, 4)); \
            SC_GROW(o[1], F1, F0, SC_LDROW(F0, 40960, 0)); \
            S[0] = S[0] * eg; SC_GROW(S[0], F0, F1, SC_LDROW(F1, 40960, 4)); \
            S[1] = S[1] * eg; SC_GROW(S[1], F1, F0, SC_LDROW(F0, 40960, 8)); \
            S[2] = S[2] * eg; SC_GROW(S[2], F0, F1, SC_LDROW(F1, 40960, 12)); \
            S[3] = S[3] * eg; SC_GROW(S[3], F1, F0, (void)0); \
            asm volatile("s_waitcnt lgkmcnt(0)\n\ts_barrier" ::: "memory");     \
            _Pragma("unroll") for (int i = 0; i < 2; ++i) \
                _Pragma("unroll") for (int r = 0; r < 16; ++r) ot[(32 * i + crow(r, hi)) * 132 + 32 * wave + n] = o[i][r]; \
            asm volatile("s_waitcnt lgkmcnt(0)\n\ts_barrier" ::: "memory");     \
        } while (0)
        SC_ULD(Ua, ega, 0);
        __syncthreads();
        for (int c = 0; c < nsteps; ++c) { if ((c & 31) == 16 && c + 16 < nsteps) SC_WAITRDY(c + 16, c + 48 < nsteps ? c + 48 : nsteps); SC_CSTEP(c, Ua, ega); }
#undef SC_ULD
#undef SC_CSTEP
        { const int t3 = fresh_tid(wave_s), n3 = t3 & 31, hi3 = (t3 >> 5) & 1;
#pragma unroll
        for (int kt = 0; kt < 4; ++kt)
#pragma unroll
            for (int r = 0; r < 16; ++r) Sout[(size_t)(32 * kt + crow(r, hi3)) * 128 + 32 * wave + n3] = S[kt][r]; }
    } else {
        const int lt = tid - 256, nrow = lt >> 2, nqd = lt & 3; const unsigned nmoff = (unsigned)(nrow * 1024 + 32 * nqd);
        u32x4 zn[4];
        float* gq = (float*)(lds + SC_OT + 64 * 132 * 4) + 32 * nqd;
        if (lt < 128) ((float*)(lds + SC_OT + 64 * 132 * 4))[lt] = gn[lt];
        u32x4 pa[14], pb[14];
        const unsigned lo16 = (unsigned)lt * 16u;
#define SC_LD(dst, cc) do { const unsigned char* sb_ = blob0 + (size_t)(cc) * bstep; _Pragma("unroll") for (int k_ = 0; k_ < 14; ++k_) dst[k_] = *(const GAS u32x4*)(sb_ + (size_t)(4096 * k_) + lo16); } while (0)
#define SC_ST(src, stage_) do { unsigned char* sd_ = lds + (stage_) * BLOB_A; _Pragma("unroll") for (int k_ = 0; k_ < 14; ++k_) *(u32x4*)(sd_ + lo16 + 4096 * k_) = src[k_]; } while (0)
#define SC_STEP(c, PREG) do { \
            u32x4 zc[4]; \
            _Pragma("unroll") for (int k = 0; k < 4; ++k) zc[k] = zn[k]; \
            { const bf16_t* zp = Z + ((size_t)(ch0 + (c)) * 64) * 1024 + h * 128 + nmoff; \
              _Pragma("unroll") for (int k = 0; k < 4; ++k) zn[k] = *(const GAS u32x4*)(zp + 8 * k); } \
            if ((c) + 1 < nsteps) SC_ST(PREG, ((c) + 1) & 1);          \
            if ((c) + 3 < nsteps) SC_LD(PREG, (c) + 3);                 \
            if ((c) > 0) SC_NORM((c) - 1, zc); \
            asm volatile("s_waitcnt lgkmcnt(0)\n\ts_barrier" ::: "memory");     \
            asm volatile("s_waitcnt lgkmcnt(0)\n\ts_barrier" ::: "memory");     \
        } while (0)
        SC_DMA(blob0, 0);
        if (1 < nsteps) SC_LD(pa, 1);
        if (2 < nsteps) SC_LD(pb, 2);
        __syncthreads();
        for (int c = 0; c < nsteps; c += 8) {
            if ((c & 31) == 16 && c + 16 < nsteps) SC_WAITRDY(c + 16, c + 48 < nsteps ? c + 48 : nsteps);
            SC_STEP(c, pa);
            if (c + 1 < nsteps) SC_STEP(c + 1, pb);
            if (c + 2 < nsteps) SC_STEP(c + 2, pa);
            if (c + 3 < nsteps) SC_STEP(c + 3, pb);
            if (c + 4 < nsteps) SC_STEP(c + 4, pa);
            if (c + 5 < nsteps) SC_STEP(c + 5, pb);
            if (c + 6 < nsteps) SC_STEP(c + 6, pa);
            if (c + 7 < nsteps) SC_STEP(c + 7, pb);
        }
#undef SC_LD
#undef SC_ST
#undef SC_STEP
        SC_NORM(nsteps - 1, zn);
    }
    __syncthreads();
#undef SC_WAITRDY
#undef SC_DMA
#undef SC_BS
#undef SC_NORM
}


#define XB_TMO      128
#define XB_XCNT(j)  (256  + 64 * (j))
#define XB_XSUB(j)  (1280 + 64 * (j))
#define XB_XGEN(j)  (2304 + 64 * (j))
#define XB_TOP      3328
#define XB_TOPGEN   3392
#define XCD_BAR_WORDS 3456
#define XB_SPIN_CAP (1u << 18)
__device__ __forceinline__ unsigned xb_ld(unsigned* p)              { return __hip_atomic_load(p, __ATOMIC_RELAXED, __HIP_MEMORY_SCOPE_AGENT); }
__device__ __forceinline__ unsigned xb_add(unsigned* p, unsigned v) { return __hip_atomic_fetch_add(p, v, __ATOMIC_RELAXED, __HIP_MEMORY_SCOPE_AGENT); }
__device__ __forceinline__ unsigned xb_xcc_id() { return (unsigned)__builtin_amdgcn_s_getreg((3 << 11) | 20) & 0xFu; }
#define XB_SPIN(cond, bar) do { unsigned _sp = 0; while (cond) { __builtin_amdgcn_s_sleep(1); \
    if ((++_sp & 255u) == 0u) { if (xb_ld(&(bar)[XB_TMO])) break; if (_sp > XB_SPIN_CAP) { atomicAdd(&(bar)[XB_TMO], 1u); break; } } } } while (0)
struct XcdBarrier { unsigned* bar; unsigned x; volatile LAS unsigned* st; };
__device__ __forceinline__ XcdBarrier xcd_barrier_post(unsigned* bar, volatile LAS unsigned* st, bool leader) {
    XcdBarrier b; b.bar = bar; b.x = xb_xcc_id(); b.st = st;
    if (leader) (void)xb_add(&bar[XB_XCNT(b.x)], 1u);
    return b;
}
__device__ __forceinline__ void xcd_barrier_complete(unsigned* bar, unsigned x, unsigned& nloc, unsigned& nx) {
    const unsigned G = gridDim.x * gridDim.y * gridDim.z;
    unsigned sum, cnt, mine, sp = 0u;
    for (;;) {
        sum = 0u; cnt = 0u; mine = 0u;
#pragma unroll
        for (unsigned j = 0; j < 16; ++j) { const unsigned c = xb_ld(&bar[XB_XCNT(j)]); sum += c; cnt += (c > 0u) ? 1u : 0u; mine = (j == x) ? c : mine; }
        if (sum == G) break;
        __builtin_amdgcn_s_sleep(1);
        if ((++sp & 255u) == 0u) { if (xb_ld(&bar[XB_TMO])) break; if (sp > XB_SPIN_CAP) { atomicAdd(&bar[XB_TMO], 1u); break; } }
    }
    nloc = mine > 0u ? mine : 1u; nx = cnt > 0u ? cnt : 1u;
}
__device__ __forceinline__ void xcd_barrier(const XcdBarrier& b, bool leader) {
    asm volatile("s_waitcnt vmcnt(0)" ::: "memory");
    __syncthreads();
    if (leader) {
        unsigned* bar = b.bar;
        __builtin_amdgcn_s_waitcnt(0);
        unsigned nloc = b.st[0], nx = b.st[1];
        if (nloc == 0u) { xcd_barrier_complete(bar, b.x, nloc, nx); b.st[0] = nloc; b.st[1] = nx; }
        const unsigned old = xb_add(&bar[XB_XSUB(b.x)], 1u);
        const unsigned gen = old / nloc;
        if (old + 1u == (gen + 1u) * nloc) {
            __builtin_amdgcn_fence(__ATOMIC_RELEASE, "agent");
            asm volatile("s_waitcnt vmcnt(0)" ::: "memory");
            const unsigned og = xb_add(&bar[XB_TOP], 1u);
            const unsigned tg = og / nx;
            if (og + 1u == (tg + 1u) * nx) xb_add(&bar[XB_TOPGEN], 1u);
            else XB_SPIN(xb_ld(&bar[XB_TOPGEN]) == tg, bar);
            __builtin_amdgcn_fence(__ATOMIC_ACQUIRE, "agent");
            xb_add(&bar[XB_XGEN(b.x)], 1u);
            asm volatile("s_waitcnt vmcnt(0)" ::: "memory");
        } else {
            XB_SPIN(xb_ld(&bar[XB_XGEN(b.x)]) == gen, bar);
            __builtin_amdgcn_fence(__ATOMIC_ACQUIRE, "agent");
            asm volatile("s_waitcnt vmcnt(0)" ::: "memory");
        }
    }
    __syncthreads();
}
#define IDS const int tid = fresh_tid(wave_s); const int lane = tid & 63, wave = wave_s; const int gw = bid * 8 + wave; const size_t gtid = (size_t)bid * 512 + tid; (void)lane; (void)gw; (void)gtid;
#define GSYNC() xcd_barrier(xbar, fresh_tid(wave_s) == 0)
template <int l>
__device__ __forceinline__ void layer_body(const Params& p, unsigned char* lds, int* s_item_p, int wave_s, const XcdBarrier& xbar) {
    const int G = gridDim.x, bid = blockIdx.x;
    const int NGW = G * 8; const size_t NGT = (size_t)G * 512;
#define PHASE_WS unsigned char* ws = p.ws; asm volatile("" : "+s"(ws)); float* outp = p.out; asm volatile("" : "+s"(outp)); unsigned* ctl = (unsigned*)(ws + WS_CTL); float* ssq = (float*)(ws + WS_SSP); float* X = (float*)(ws + WS_X); bf16_t* XN = (bf16_t*)(ws + WS_XN); unsigned char* wl = ws + WS_W + (size_t)l * W_LSTRIDE; (void)ctl; (void)ssq; (void)X; (void)XN; (void)wl; (void)outp;
    LAS unsigned char* lds3 = (LAS unsigned char*)lds;
    (void)NGW; (void)NGT;
#define s_item (*s_item_p)
        {
            PHASE_WS
            pg8::Gemm g{XN, (const bf16_t*)wl, M, NIN, 1024}; pg8::StaticOrder S; S.init(M, NIN, G, bid);
            EpiIn E; E.ss = ssq + (size_t)(2 * l) * M * 16; E.QA = (bf16_t*)(ws + WS_QA); E.KP = (bf16_t*)(ws + WS_KP); E.KS = (bf16_t*)(ws + WS_KS); E.VTP = (bf16_t*)(ws + WS_VTP); E.VTS = (bf16_t*)(ws + WS_VTS);
            E.QKVB = (bf16_t*)(ws + WS_QKVB); E.Z = (bf16_t*)(ws + WS_Z); E.GA = (bf16_t*)(ws + WS_GA); E.GB = (bf16_t*)(ws + WS_GB); E.BA = (float*)(ws + WS_BA);
            E.okp = outp + O_KP + (size_t)l * 16777216; E.ovp = outp + O_VP + (size_t)l * 16777216; E.oks = outp + O_KS + (size_t)l * 524288; E.ovs = outp + O_VS + (size_t)l * 524288;
            E.ogcp = outp + O_GCP + (size_t)l * 9216; E.ogcs = outp + O_GCS + (size_t)l * 73728;

#ifndef NO_G1
            pg8::gemm_phase<EpiIn, true, true>(lds3, g, S, E, wave_s);
#endif
        }
        GSYNC();
        {
            PHASE_WS
            IDS
#ifndef NO_PREP
            {
                const bf16_t* KPp = (const bf16_t*)(ws + WS_KP); float mxr = 0.f;
                for (int row = gw; row < TP; row += NGW) { const u32x4 a = *(const u32x4*)(KPp + (size_t)row * 1024 + lane * 16), b = *(const u32x4*)(KPp + (size_t)row * 1024 + lane * 16 + 8);
                    float ss = (bflo(a.x) * bflo(a.x) + bfhi(a.x) * bfhi(a.x)) + (bflo(a.y) * bflo(a.y) + bfhi(a.y) * bfhi(a.y)) + (bflo(a.z) * bflo(a.z) + bfhi(a.z) * bfhi(a.z)) + (bflo(a.w) * bflo(a.w) + bfhi(a.w) * bfhi(a.w))
                             + (bflo(b.x) * bflo(b.x) + bfhi(b.x) * bfhi(b.x)) + (bflo(b.y) * bflo(b.y) + bfhi(b.y) * bfhi(b.y)) + (bflo(b.z) * bflo(b.z) + bfhi(b.z) * bfhi(b.z)) + (bflo(b.w) * bflo(b.w) + bfhi(b.w) * bfhi(b.w));
                    ss += __shfl_xor(ss, 1); ss += __shfl_xor(ss, 2); mxr = fmaxf(mxr, ss); }
                if ((lane & 3) == 0) atomicMax(ctl + 16 + l * 16 + (lane >> 2), __float_as_uint(mxr));
            }
#endif
        }
        GSYNC();
        {
            PHASE_WS
            float lam, lam0;
            { float s1 = 0.f, s2 = 0.f;
              const float* q1 = INP(9) + l * 64; const float* k1 = INP(10) + l * 64; const float* q2 = INP(11) + l * 64; const float* k2 = INP(12) + l * 64;
              for (int i = 0; i < 64; ++i) { s1 += q1[i] * k1[i]; s2 += q2[i] * k2[i]; }
              lam0 = uni(0.8f - 0.6f * __expf(-0.3f * (float)l)); lam = uni(__expf(s1) - __expf(s2) + lam0); }
            if (fresh_tid(wave_s) == 0) { ((float*)s_item_p)[1] = lam; ((float*)s_item_p)[2] = 1.f - lam0; }
            const float* subg = INP(13) + l * 128;
            for (;;) {
                __syncthreads();
                if (fresh_tid(wave_s) == 0) s_item = (int)atomicAdd(ctl + l, 1u);
                __syncthreads();
                asm volatile("" : "+s"(ws), "+s"(outp));
                int it = __builtin_amdgcn_readfirstlane(s_item);
                if (it >= 3272) break;
                int kind, idx;
                if (it < 8) { kind = 0; idx = it; }
                else if (it < 72) { kind = 3; idx = it - 8; }
                else if (it < 328) { kind = 1; idx = it - 72; }
                else if (it < 840) { kind = 5; idx = it - 328; }
                else if (it < 904) { kind = 2; idx = it - 840; }
                else if (it < 2976) { const int r = it - 904, blk = r / 296, o = r - blk * 296; if (o < 64) { kind = 3; idx = 64 + blk * 64 + o; } else { kind = 1; idx = 256 + blk * 232 + (o - 64); } }
                else if (it < 3208) { kind = 1; idx = 1880 + (it - 2976); }
                else { kind = 4; idx = it - 3208; }
                unsigned* rdyb = ctl + 8192 + l * 2112;
                if (kind == 0) {
                    gdn_scan_unit(lds, ws, INP(17) + l * 128, 0, 256, idx, nullptr, outp + O_GP + (size_t)l * 131072 + (size_t)idx * 16384, wave_s, rdyb + idx * 264);
                } else if (kind == 1) {
                    gdn_prep_unit(lds, p, l, idx >> 3, idx & 7, wave_s);
                } else if (kind == 5) {
                    cache_conv_unit(lds, p, ws, l, idx & 7, idx >> 3, wave_s);
                } else if (kind == 2) {
                    const int b = idx >> 3, h = idx & 7; const float sl2 = uni(exp2f(-(float)(h + 1)) * LOG2E);
                    {
                        if (fresh_tid(wave_s) == 0) { unsigned sp = 0; while (__hip_atomic_load(ctl + 48 + l * 8 + b, __ATOMIC_RELAXED, __HIP_MEMORY_SCOPE_AGENT) < 64u) { __builtin_amdgcn_s_sleep(8); if (++sp > (1u << 24)) break; } }
                        __syncthreads(); __builtin_amdgcn_fence(__ATOMIC_ACQUIRE, "agent"); }
                    attn_unit(lds, (const bf16_t*)(ws + WS_QA) + (size_t)(TP + 64 * b) * 1024 + h * 128, (const bf16_t*)(ws + WS_KS) + (size_t)b * KVS * 1024 + h * 128,
                              (const bf16_t*)(ws + WS_VTS) + (size_t)((b * 8 + h) * 128) * KVS, KVS, (bf16_t*)(ws + WS_OA) + (size_t)(TP + 64 * b) * 1024 + h * 128,
                              2, PAST, 65, sl2, (const float*)s_item_p + 1, subg, wave_s, nullptr);
                } else if (kind == 3) {
                    const int qb = 63 - (idx >> 3), h = idx & 7; const float sl2 = uni(exp2f(-(float)(h + 1)) * LOG2E);
                    attn_unit(lds, (const bf16_t*)(ws + WS_QA) + (size_t)(256 * qb) * 1024 + h * 128, (const bf16_t*)(ws + WS_KP) + h * 128,
                              (const bf16_t*)(ws + WS_VTP) + (size_t)(h * 128) * TP, TP, (bf16_t*)(ws + WS_OA) + (size_t)(256 * qb) * 1024 + h * 128,
                              8, 256 * qb, 4 * qb + 4, sl2, (const float*)s_item_p + 1, subg, wave_s, ctl + 16 + l * 16 + h * 2);
                } else {
                    const int b = idx >> 3, h = idx & 7;
                    gdn_scan_unit(lds, ws, INP(17) + l * 128, 256 + b, 1, h, INP(4) + ((size_t)(l * 8 + b) * 8 + h) * 16384, outp + O_GS + (size_t)l * 1048576 + ((size_t)b * 8 + h) * 16384, wave_s, rdyb + h * 264 + 256 + b);
                }
            }
        }
        GSYNC();
        {
            PHASE_WS
            pg8::StaticOrder S; S.init(M, 1024, G, bid);
            { pg8::Gemm g{(const bf16_t*)(ws + WS_OA), (const bf16_t*)(wl + 19 * MiB), M, 1024, 1024}; EpiGateA E{(const bf16_t*)(ws + WS_GA), (float*)(ws + WS_MG)};

#if !defined(NO_G2) && !defined(NO_G2A)
              pg8::gemm_phase<EpiGateA, true, true>(lds3, g, S, E, wave_s);
#endif
 }
            __syncthreads();
            { pg8::Gemm g{(const bf16_t*)(ws + WS_OB), (const bf16_t*)(wl + 21 * MiB), M, 1024, 1024}; EpiGateB E{(const bf16_t*)(ws + WS_GB), (const float*)(ws + WS_MG), (bf16_t*)(ws + WS_MERGED)};

#if !defined(NO_G2) && !defined(NO_G2B)
              pg8::gemm_phase<EpiGateB, true, true>(lds3, g, S, E, wave_s);
#endif
 }
        }
        GSYNC();
        {
            PHASE_WS
            pg8::Gemm g{(const bf16_t*)(ws + WS_MERGED), (const bf16_t*)(wl + 23 * MiB), M, 1024, 1024}; pg8::StaticOrder S; S.init(M, 1024, G, bid);
            EpiRes E{X, INP(21) + l * 1024, XN, ssq + (size_t)(2 * l + 1) * M * 16};
#if !defined(NO_G2) && !defined(NO_G2R)
            pg8::gemm_phase<EpiRes, true, true>(lds3, g, S, E, wave_s);
#endif
        }
        GSYNC();
        {
            PHASE_WS
            pg8::Gemm g{XN, (const bf16_t*)(wl + 25 * MiB), M, FF2, 1024}; pg8::StaticOrder S; S.init(M, FF2, G, bid);
            EpiUp E{ssq + (size_t)(2 * l + 1) * M * 16, (bf16_t*)(ws + WS_U), outp + O_FCP + (size_t)l * 11264, outp + O_FCS + (size_t)l * 90112};
#if !defined(NO_G2) && !defined(NO_G2U)
            pg8::gemm_phase<EpiUp, true, true>(lds3, g, S, E, wave_s);
#endif
        }
        GSYNC();
        {
            PHASE_WS
            IDS
            const bf16_t* U = (const bf16_t*)(ws + WS_U); bf16_t* ACT = (bf16_t*)(ws + WS_ACT);
            const float* cw = INP(23) + (size_t)l * 3 * FF2; const float* cb = INP(24) + (size_t)l * FF2;
            for (size_t it_ = gtid; it_ < (size_t)(M / 16) * 352 * PROBE_MISC; it_ += NGT) { const size_t it = it_ % ((size_t)(M / 16) * 352);
                const int seg = (int)(it / 352), cg8 = (int)(it % 352), f0 = cg8 * 8, r0 = seg * 16;
                float wg[3][8], wv[3][8], bg[8], bv[8];
#pragma unroll
                for (int j = 0; j < 8; ++j) { bg[j] = cb[f0 + j]; bv[j] = cb[FF + f0 + j];
#pragma unroll
                    for (int k = 0; k < 3; ++k) { wg[k][j] = cw[k * FF2 + f0 + j]; wv[k][j] = cw[k * FF2 + FF + f0 + j]; } }
                float g2[8], g1[8], v2[8], v1[8];
                const bool samp = r0 >= TP; const int spos = samp ? ((r0 - TP) & 63) : r0;
                if (spos == 0) {
                    if (samp) { const float* sc = INP(6) + ((size_t)(l * 8 + ((r0 - TP) >> 6)) * 2) * FF2;
#pragma unroll
                        for (int j = 0; j < 8; ++j) { g2[j] = sc[f0 + j]; v2[j] = sc[FF + f0 + j]; g1[j] = sc[FF2 + f0 + j]; v1[j] = sc[FF2 + FF + f0 + j]; } }
                    else {
#pragma unroll
                        for (int j = 0; j < 8; ++j) { g2[j] = 0.f; v2[j] = 0.f; g1[j] = 0.f; v1[j] = 0.f; } }
                } else {
                    const u32x4 a2 = *(const u32x4*)(U + (size_t)(r0 - 2) * FF2 + f0), b2 = *(const u32x4*)(U + (size_t)(r0 - 2) * FF2 + FF + f0);
                    const u32x4 a1 = *(const u32x4*)(U + (size_t)(r0 - 1) * FF2 + f0), b1 = *(const u32x4*)(U + (size_t)(r0 - 1) * FF2 + FF + f0);
                    g2[0] = bflo(a2.x); g2[1] = bfhi(a2.x); g2[2] = bflo(a2.y); g2[3] = bfhi(a2.y); g2[4] = bflo(a2.z); g2[5] = bfhi(a2.z); g2[6] = bflo(a2.w); g2[7] = bfhi(a2.w);
                    v2[0] = bflo(b2.x); v2[1] = bfhi(b2.x); v2[2] = bflo(b2.y); v2[3] = bfhi(b2.y); v2[4] = bflo(b2.z); v2[5] = bfhi(b2.z); v2[6] = bflo(b2.w); v2[7] = bfhi(b2.w);
                    g1[0] = bflo(a1.x); g1[1] = bfhi(a1.x); g1[2] = bflo(a1.y); g1[3] = bfhi(a1.y); g1[4] = bflo(a1.z); g1[5] = bfhi(a1.z); g1[6] = bflo(a1.w); g1[7] = bfhi(a1.w);
                    v1[0] = bflo(b1.x); v1[1] = bfhi(b1.x); v1[2] = bflo(b1.y); v1[3] = bfhi(b1.y); v1[4] = bflo(b1.z); v1[5] = bfhi(b1.z); v1[6] = bflo(b1.w); v1[7] = bfhi(b1.w);
                }
#pragma unroll 4
                for (int rr = 0; rr < 16; ++rr) {
                    const size_t row = (size_t)(r0 + rr);
                    const u32x4 a0 = *(const u32x4*)(U + row * FF2 + f0), b0 = *(const u32x4*)(U + row * FF2 + FF + f0);
                    float g0[8], v0[8], o[8];
                    g0[0] = bflo(a0.x); g0[1] = bfhi(a0.x); g0[2] = bflo(a0.y); g0[3] = bfhi(a0.y); g0[4] = bflo(a0.z); g0[5] = bfhi(a0.z); g0[6] = bflo(a0.w); g0[7] = bfhi(a0.w);
                    v0[0] = bflo(b0.x); v0[1] = bfhi(b0.x); v0[2] = bflo(b0.y); v0[3] = bfhi(b0.y); v0[4] = bflo(b0.z); v0[5] = bfhi(b0.z); v0[6] = bflo(b0.w); v0[7] = bfhi(b0.w);
#pragma unroll
                    for (int j = 0; j < 8; ++j) { const float gc = wg[0][j] * g2[j] + wg[1][j] * g1[j] + wg[2][j] * g0[j] + bg[j]; const float vc = wv[0][j] * v2[j] + wv[1][j] * v1[j] + wv[2][j] * v0[j] + bv[j];
                        o[j] = siluf_(gc) * vc; g2[j] = g1[j]; g1[j] = g0[j]; v2[j] = v1[j]; v1[j] = v0[j]; }
                    u32x4 w; w.x = pk2(o[0], o[1]); w.y = pk2(o[2], o[3]); w.z = pk2(o[4], o[5]); w.w = pk2(o[6], o[7]);
                    *(u32x4*)(ACT + row * FF + f0) = w;
                }
            }
        }
        GSYNC();
        {
            PHASE_WS
            pg8::Gemm g{(const bf16_t*)(ws + WS_ACT), (const bf16_t*)(wl + 36 * MiB), M, 1024, FF}; pg8::StaticOrder S; S.init(M, 1024, G, bid);
            EpiRes E{X, l == 0 ? INP(7) + 1024 : INP(26), XN, ssq + (size_t)(2 * l + 2) * M * 16};
#if !defined(NO_G2) && !defined(NO_G2R)
            pg8::gemm_phase<EpiRes, true, true>(lds3, g, S, E, wave_s);
#endif
        }
        GSYNC();
#undef s_item
}

__global__ void __launch_bounds__(512, 2) hybrid_fwd(Params p) {
    extern __shared__ __attribute__((aligned(16))) unsigned char lds[];
    cg::grid_group grid = cg::this_grid();
    const int wave_s = __builtin_amdgcn_readfirstlane((int)(threadIdx.x >> 6));
    const int G = gridDim.x, bid = blockIdx.x;
    const int NGW = G * 8; const size_t NGT = (size_t)G * 512;
    unsigned char* ws = p.ws;
    unsigned* ctl = (unsigned*)(ws + WS_CTL);
    float* ssq = (float*)(ws + WS_SSP);
    float* X = (float*)(ws + WS_X); bf16_t* XN = (bf16_t*)(ws + WS_XN);
    LAS unsigned char* lds3 = (LAS unsigned char*)lds;
    __shared__ int s_item[8];

    if (fresh_tid(wave_s) == 0) { s_item[4] = 0; s_item[5] = 0; }
    __syncthreads();
    const XcdBarrier xbar = xcd_barrier_post(ctl + 4096, (volatile LAS unsigned*)(LAS int*)s_item + 4, fresh_tid(wave_s) == 0);
    {
    IDS
    {
        float* scr = (float*)(lds + wave * 8448);
        constexpr int I_A = 16 * 192, I_B = 16 * 96, I_P = 16 * 32, I_UP = 16 * 176, I_DN = 44 * 32;
        constexpr int PER_L = I_A + I_B + 3 * I_P + I_UP + I_DN;
        for (int it_ = gw; it_ < 2 * PER_L * PROBE_MISC; it_ += NGW) { const int it = it_ % (2 * PER_L);
            const int l = it / PER_L; int r = it % PER_L;
            unsigned char* wl = ws + WS_W + (size_t)l * W_LSTRIDE;
            const float* src; size_t sp; bf16_t* dst; size_t dp; int kb, nb;
            if (r < I_A) { kb = r / 192; nb = r % 192; src = INP(8) + (size_t)l * 1024 * 9232 + (size_t)(64 * kb) * 9232 + 32 * nb; sp = 9232; dst = (bf16_t*)wl + (size_t)(32 * nb) * 1024 + 64 * kb; dp = 1024; }
            else if ((r -= I_A) < I_B) { kb = r / 96; nb = r % 96; src = INP(8) + (size_t)l * 1024 * 9232 + (size_t)(64 * kb) * 9232 + 6160 + 32 * nb; sp = 9232; dst = (bf16_t*)wl + (size_t)(6144 + 32 * nb) * 1024 + 64 * kb; dp = 1024; }
            else if ((r -= I_B) < I_P) { kb = r / 32; nb = r % 32; src = INP(18) + (size_t)l * 1024 * 1024 + (size_t)(64 * kb) * 1024 + 32 * nb; sp = 1024; dst = (bf16_t*)(wl + 19 * MiB) + (size_t)(32 * nb) * 1024 + 64 * kb; dp = 1024; }
            else if ((r -= I_P) < I_P) { kb = r / 32; nb = r % 32; src = INP(19) + (size_t)l * 1024 * 1024 + (size_t)(64 * kb) * 1024 + 32 * nb; sp = 1024; dst = (bf16_t*)(wl + 21 * MiB) + (size_t)(32 * nb) * 1024 + 64 * kb; dp = 1024; }
            else if ((r -= I_P) < I_P) { kb = r / 32; nb = r % 32; src = INP(20) + (size_t)l * 1024 * 1024 + (size_t)(64 * kb) * 1024 + 32 * nb; sp = 1024; dst = (bf16_t*)(wl + 23 * MiB) + (size_t)(32 * nb) * 1024 + 64 * kb; dp = 1024; }
            else if ((r -= I_P) < I_UP) { kb = r / 176; nb = r % 176; src = INP(22) + (size_t)l * 1024 * FF2 + (size_t)(64 * kb) * FF2 + 32 * nb; sp = FF2; dst = (bf16_t*)(wl + 25 * MiB) + (size_t)(32 * nb) * 1024 + 64 * kb; dp = 1024; }
            else { r -= I_UP; kb = r / 32; nb = r % 32; src = INP(25) + (size_t)l * FF * 1024 + (size_t)(64 * kb) * 1024 + 32 * nb; sp = 1024; dst = (bf16_t*)(wl + 36 * MiB) + (size_t)(32 * nb) * FF + 64 * kb; dp = FF; }
            transpose_item(src, sp, dst, dp, scr, lane);
        }
        const float* win = INP(8);
        for (size_t i = gtid; i < 2 * 16 * 1024; i += NGT) { const int l = (int)(i >> 14), j = (int)((i >> 10) & 15), k = (int)(i & 1023);
            ((bf16_t*)(ws + WS_W + (size_t)l * W_LSTRIDE))[(size_t)(9216 + j) * 1024 + k] = (bf16_t)f2bf(win[(size_t)l * 1024 * 9232 + (size_t)k * 9232 + 6144 + j]); }
        const float* g0 = INP(7); const float* xin0 = INP(0); const float* xin1 = INP(1);
        for (int mrow_ = gw; mrow_ < M * PROBE_MISC; mrow_ += NGW) { const int mrow = mrow_ % M;
            const float* xr = mrow < TP ? xin0 + (size_t)mrow * 1024 : xin1 + (size_t)(mrow - TP) * 1024;
            float s = 0.f;
#pragma unroll
            for (int j = 0; j < 4; ++j) { const int c = 4 * lane + 256 * j; const f32x4 v = *(const f32x4*)(xr + c); const f32x4 gg = *(const f32x4*)(g0 + c);
                *(f32x4*)(X + (size_t)mrow * 1024 + c) = v; s += (v[0] * v[0] + v[1] * v[1]) + (v[2] * v[2] + v[3] * v[3]);
                u32x2 w; w.x = pk2(v[0] * gg[0], v[1] * gg[1]); w.y = pk2(v[2] * gg[2], v[3] * gg[3]); *(u32x2*)(XN + (size_t)mrow * 1024 + c) = w; }
            s = wave_sum(s); if (lane < 16) ssq[(size_t)mrow * 16 + lane] = lane == 0 ? s : 0.f;
        }
    }
    }
    asm volatile("s_waitcnt vmcnt(0) lgkmcnt(0)" ::: "memory"); grid.sync();

    layer_body<0>(p, lds, s_item, wave_s, xbar);
    layer_body<1>(p, lds, s_item, wave_s, xbar);
    {
        IDS
        const float* gf = INP(26); const float* ss4 = ssq + (size_t)4 * M * 16;
        for (size_t i_ = gtid; i_ < (size_t)M * 256 * PROBE_MISC; i_ += NGT) { const size_t i = i_ % ((size_t)M * 256); const size_t row = i >> 8; const int c = (int)(i & 255) * 4;
            const float rs = rsqrtf(ss16(ss4 + row * 16) * (1.f / 1024.f) + EPS); const f32x4 v = *(const f32x4*)(X + row * 1024 + c); const f32x4 gg = *(const f32x4*)(gf + c);
            *(f32x4*)(p.out + O_YP + row * 1024 + c) = v * rs * gg; }
    }
}

extern "C" void kernel_launch(void* const* d_in, const int* in_sizes, int n_in, void* d_out, int out_size, void* d_ws, size_t ws_size, hipStream_t stream) {
    static int grid_blocks = 0;
    if (!grid_blocks) {
        int dev = 0, cus = 0, per_cu = 0;
        hipGetDevice(&dev);
        hipDeviceGetAttribute(&cus, hipDeviceAttributeMultiprocessorCount, dev);
        hipFuncSetAttribute((const void*)hybrid_fwd, hipFuncAttributeMaxDynamicSharedMemorySize, LDS_BYTES);
        hipOccupancyMaxActiveBlocksPerMultiprocessor(&per_cu, (const void*)hybrid_fwd, 512, LDS_BYTES);
        if (per_cu < 1) per_cu = 1;
        if (per_cu > 1) per_cu = 1;
        grid_blocks = cus * per_cu;
        (void)hipGetLastError();
    }
    Params p{};
    for (int i = 0; i < 27; ++i) p.in[i] = (const float*)d_in[i];
    p.out = (float*)d_out; p.ws = (unsigned char*)d_ws;
    (void)hipMemsetAsync(d_ws, 0, 65536, stream);
    void* args[] = {&p};
    hipError_t e = hipLaunchCooperativeKernel((const void*)hybrid_fwd, dim3(grid_blocks), dim3(512), args, LDS_BYTES, stream);
    if (e != hipSuccess) fprintf(stderr, "cooperative launch failed: %s (grid %d)\n", hipGetErrorString(e), grid_blocks);
}
```

```cpp
#include <hip/hip_runtime.h>
#include <hip/hip_cooperative_groups.h>
#include <cstdio>
#include <cstdint>
namespace cg = cooperative_groups;

#define LAS __attribute__((address_space(3)))
#define GAS __attribute__((address_space(1)))
typedef unsigned short bf16_t;
typedef short bf16x8 __attribute__((ext_vector_type(8)));
typedef short s16x4 __attribute__((ext_vector_type(4)));
typedef float f32x4 __attribute__((ext_vector_type(4)));
typedef float f32x16 __attribute__((ext_vector_type(16)));
typedef unsigned u32x4 __attribute__((ext_vector_type(4)));
typedef unsigned u32x2 __attribute__((ext_vector_type(2)));

#ifndef PROBE_SCAN
#define PROBE_SCAN 1
#endif
#ifndef PROBE_PREP
#define PROBE_PREP 1
#endif
#ifndef PROBE_MISC
#define PROBE_MISC 1
#endif
#ifndef PROBE_P2B
#define PROBE_P2B 1
#endif
constexpr int D = 1024, TP = 16384, NSROWS = 512, M = TP + NSROWS;
constexpr int PAST = 4096, KVS = PAST + 64;
constexpr int NIN = 9472;
constexpr int FF = 2816, FF2 = 5632;
constexpr float EPS = 1e-6f;
constexpr float QSCALE = 0.125f * 1.4426950408889634f;
constexpr float LOG2E = 1.4426950408889634f;

constexpr size_t O_YP = 0, O_KP = 17301504, O_VP = 50855936, O_GP = 84410368, O_GCP = 84672512, O_FCP = 84690944,
                 O_KS = 84713472, O_VS = 85762048, O_GS = 86810624, O_GCS = 88907776, O_FCS = 89055232;

constexpr size_t MiB = 1u << 20;
constexpr size_t WS_CTL = 0;
constexpr size_t CTL_SS = 65536;
constexpr size_t WS_W = 1 * MiB, W_LSTRIDE = 42 * MiB;
constexpr size_t WS_X = 86 * MiB, WS_XN = 152 * MiB;
constexpr size_t WS_KS = 185 * MiB, WS_VTS = 250 * MiB;
constexpr size_t WS_QA = 315 * MiB, WS_KP = 348 * MiB, WS_VTP = 380 * MiB;
constexpr size_t WS_MG = 315 * MiB, WS_MERGED = 381 * MiB;
constexpr size_t WS_QKVB = 414 * MiB, WS_Z = 513 * MiB, WS_GA = 546 * MiB, WS_GB = 579 * MiB, WS_BA = 612 * MiB;
constexpr size_t WS_U = 414 * MiB;
constexpr size_t WS_GDNP = 614 * MiB, WS_ACT = 614 * MiB;
constexpr size_t WS_OA = 798 * MiB, WS_OB = 831 * MiB;
constexpr size_t WS_SSP = 864 * MiB;
constexpr size_t BLOB = 91136;
constexpr int BLOB_A = 57344, BLOB_U = 57344, BLOB_EG = 90112;
constexpr int LDS_BYTES = 155648;

__device__ __forceinline__ unsigned f2bf(float f) { unsigned u = __builtin_bit_cast(unsigned, f); return (u + 0x7fffu + ((u >> 16) & 1u)) >> 16; }
typedef float f32x2_t __attribute__((ext_vector_type(2))); typedef __bf16 bf16x2_t __attribute__((ext_vector_type(2)));
__device__ __forceinline__ unsigned pk2(float lo, float hi) { f32x2_t v = {lo, hi}; bf16x2_t b = __builtin_convertvector(v, bf16x2_t); return __builtin_bit_cast(unsigned, b); }
__device__ __forceinline__ float bf2f(bf16_t b) { return __uint_as_float((unsigned)b << 16); }
__device__ __forceinline__ float bflo(unsigned w) { return __uint_as_float(w << 16); }
__device__ __forceinline__ float bfhi(unsigned w) { return __uint_as_float(w & 0xffff0000u); }
__device__ __forceinline__ float sigmoidf_(float x) { return __builtin_amdgcn_rcpf(1.f + __expf(-x)); }
__device__ __forceinline__ float siluf_(float x) { return x * __builtin_amdgcn_rcpf(1.f + __expf(-x)); }
__device__ __forceinline__ void st_bf8(bf16_t* p, f32x4 a, f32x4 b) { u32x4 w; w.x = pk2(a[0], a[1]); w.y = pk2(a[2], a[3]); w.z = pk2(b[0], b[1]); w.w = pk2(b[2], b[3]); *(u32x4*)p = w; }
__device__ __forceinline__ void st_f8(float* p, f32x4 a, f32x4 b) { *(f32x4*)p = a; *(f32x4*)(p + 4) = b; }
__device__ __forceinline__ bf16x8 pack8(float a0, float a1, float a2, float a3, float a4, float a5, float a6, float a7) {
    u32x4 w; w.x = pk2(a0, a1); w.y = pk2(a2, a3); w.z = pk2(a4, a5); w.w = pk2(a6, a7); return __builtin_bit_cast(bf16x8, w); }
__device__ __forceinline__ float wave_sum(float v) {
#pragma unroll
    for (int o = 1; o < 64; o <<= 1) v += __shfl_xor(v, o);
    return v;
}
__device__ __forceinline__ float ss16(const float* p) { const f32x4 a = *(const f32x4*)p, b = *(const f32x4*)(p + 4), c = *(const f32x4*)(p + 8), d = *(const f32x4*)(p + 12);
    return (((a[0] + a[1]) + (a[2] + a[3])) + ((b[0] + b[1]) + (b[2] + b[3]))) + (((c[0] + c[1]) + (c[2] + c[3])) + ((d[0] + d[1]) + (d[2] + d[3]))); }
__device__ __forceinline__ int fresh_tid(int wave_s) { unsigned m = ~0u; asm volatile("" : "+s"(m)); return wave_s * 64 + (int)__builtin_amdgcn_mbcnt_hi(m, __builtin_amdgcn_mbcnt_lo(m, 0u)); }
__device__ __forceinline__ int crow(int r, int hi) { return (r & 3) + 8 * (r >> 2) + 4 * hi; }

namespace pg8 {
constexpr int BM = 256, BK = 64, HALF = 128, HTB = HALF * BK * 2, STAGE_BYTES = 8 * HTB, NXCD = 8, WGM = 8;
__host__ __device__ __forceinline__ int lds_byte(int r, int c) { const int st = (r >> 4) * 2 + (c >> 5), rr = r & 15, cc = c & 31, ob = rr * 64 + cc * 2; return st * 1024 + (ob ^ (((ob >> 9) & 1) << 5)); }
__host__ __device__ __forceinline__ void stage_rc(int b, int& R, int& C) { const int st = b / 1024, sb = b % 1024, swz = sb ^ (((sb >> 9) & 1) << 5); R = (st >> 1) * 16 + swz / 64; C = (st & 1) * 32 + (swz % 64) / 2; }
__host__ __device__ __forceinline__ int perm32(int rho) { const int n = rho >> 4, i = rho & 15; return 8 * (i >> 2) + 4 * n + (i & 3); }
struct Unit { int pm, pn; };
struct Gemm { const bf16_t* A; const bf16_t* Bt; int M, N, K; };
struct StaticOrder {
    int nM, nN, nwg, G, c;
    __host__ __device__ void init(int M_, int N_, int G_, int c_) { nM = M_ / BM; nN = N_ / BM; nwg = nM * nN; G = G_; c = c_; }
    __host__ __device__ bool next(int i, Unit& u) const {
        const long L = (long)i * G + c; if (L >= nwg) return false;
        int wgid = (int)L; { const int q = nwg / NXCD, r = nwg % NXCD, xcd = wgid % NXCD, off = wgid / NXCD; wgid = (xcd < r ? xcd * (q + 1) : r * (q + 1) + (xcd - r) * q) + off; }
        const int nig = WGM * nN, gid = wgid / nig, fm = gid * WGM, gsz = (nM - fm) < WGM ? (nM - fm) : WGM;
        u.pm = fm + ((wgid % nig) % gsz); u.pn = (wgid % nig) / gsz; return true;
    }
};
template <class Epi, bool ALIGN_EPI, bool SP2>
__device__ __forceinline__ void gemm_phase(LAS unsigned char* lds, const Gemm g, const StaticOrder& S, const Epi& E, int wave_s) {
    const int tid = fresh_tid(wave_s);
    const int wid = wave_s, lane = tid & 63, wr = wid >> 2, wc = wid & 3, fr = lane & 15, fq = lane >> 4;
    const int K = g.K, nt = K / BK;
    unsigned voffA[2], voffB[2];
#pragma unroll
    for (int i = 0; i < 2; ++i) { int R, C; stage_rc(tid * 16 + i * 8192, R, C); const int Rb = Epi::PERM ? ((R & ~31) + perm32(R & 31)) : R;
        voffA[i] = (unsigned)(R * K + C) * 2u; voffB[i] = (unsigned)(Rb * K + C) * 2u; }
    const size_t kstep = (size_t)(BK * 2);
    const size_t hstep = (size_t)HALF * K * 2;
    const size_t tstep = 2 * hstep;
    const unsigned ldsw = (unsigned)wid * 1024u;
    const int aoff = lds_byte(wr * 64 + fr, fq * 8), boff = lds_byte(wc * 32 + fr, fq * 8);
#define PG8_SA(b, h) (((b) * 2 + (h)) * HTB)
#define PG8_SB(b, h) ((4 + (b) * 2 + (h)) * HTB)
#define PG8_STAGE(bufoff, gbase, voff) do { _Pragma("unroll") for (int _i = 0; _i < 2; ++_i) \
        __builtin_amdgcn_global_load_lds((const unsigned*)((const char*)(gbase) + (voff)[_i]), (LAS unsigned*)(lds + (bufoff) + ldsw + _i * 8192), 16, 0, 0); } while (0)
#define PG8_LDA(dst, b, h) do { _Pragma("unroll") for (int m = 0; m < 4; ++m) _Pragma("unroll") for (int k = 0; k < 2; ++k) dst[m][k] = *(const LAS bf16x8*)(lds + PG8_SA(b, h) + aoff + m * 2048 + k * 1024); } while (0)
#define PG8_LDB(dst, b, h) do { _Pragma("unroll") for (int n = 0; n < 2; ++n) _Pragma("unroll") for (int k = 0; k < 2; ++k) dst[n][k] = *(const LAS bf16x8*)(lds + PG8_SB(b, h) + boff + n * 2048 + k * 1024); } while (0)
#define PG8_MMA(ai, bj, At, Bt) do { __builtin_amdgcn_s_setprio(1); _Pragma("unroll") for (int m = 0; m < 4; ++m) _Pragma("unroll") for (int n = 0; n < 2; ++n) _Pragma("unroll") for (int k = 0; k < 2; ++k) \
        acc[ai][bj][m][n] = __builtin_amdgcn_mfma_f32_16x16x32_bf16(Bt[n][k], At[m][k], acc[ai][bj][m][n], 0, 0, 0); __builtin_amdgcn_s_setprio(0); } while (0)
#define PG8_WAIT_V(n) asm volatile("s_waitcnt vmcnt(" #n ")" ::: "memory")
#define PG8_WAIT_L(n) asm volatile("s_waitcnt lgkmcnt(" #n ")" ::: "memory")
#define PG8_BAR __builtin_amdgcn_s_barrier()
#define PG8_SCHED __builtin_amdgcn_sched_barrier(0)
    Unit cur, nxt; int ui = 0;
    if (!S.next(0, cur)) return;
    f32x4 acc[2][2][4][2];
#pragma unroll
    for (int a = 0; a < 2; ++a)
#pragma unroll
        for (int b = 0; b < 2; ++b)
#pragma unroll
            for (int m = 0; m < 4; ++m)
#pragma unroll
                for (int n = 0; n < 2; ++n) acc[a][b][m][n] = (f32x4){0.f, 0.f, 0.f, 0.f};
    bf16x8 At[4][2], B0[2][2], B1[2][2];
    const char* cA = (const char*)g.A + (size_t)cur.pm * tstep; const char* cB = (const char*)g.Bt + (size_t)cur.pn * tstep;
    if constexpr (SP2) {
        PG8_STAGE(PG8_SB(0, 0), cB, voffB); PG8_STAGE(PG8_SB(0, 1), cB + hstep, voffB); PG8_STAGE(PG8_SA(0, 0), cA, voffA); PG8_STAGE(PG8_SA(0, 1), cA + hstep, voffA);
        if (wr == 1) PG8_BAR;
        PG8_WAIT_V(2); PG8_BAR;
        PG8_STAGE(PG8_SB(1, 0), cB + kstep, voffB); PG8_STAGE(PG8_SA(1, 0), cA + kstep, voffA); PG8_STAGE(PG8_SB(1, 1), cB + hstep + kstep, voffB);
        PG8_WAIT_V(6); PG8_BAR;
    } else {
        PG8_STAGE(PG8_SB(0, 0), cB, voffB); PG8_STAGE(PG8_SA(0, 0), cA, voffA); PG8_STAGE(PG8_SB(0, 1), cB + hstep, voffB); PG8_STAGE(PG8_SA(0, 1), cA + hstep, voffA);
        if (wr == 1) PG8_BAR;
        PG8_WAIT_V(4); PG8_BAR;
        PG8_STAGE(PG8_SB(1, 0), cB + kstep, voffB); PG8_STAGE(PG8_SA(1, 0), cA + kstep, voffA); PG8_STAGE(PG8_SB(1, 1), cB + hstep + kstep, voffB);
        PG8_WAIT_V(6); PG8_BAR;
    }
    for (;;) {
        const bool has_next = S.next(ui + 1, nxt);
        const char* nA = has_next ? (const char*)g.A + (size_t)nxt.pm * tstep : cA; const char* nB = has_next ? (const char*)g.Bt + (size_t)nxt.pn * tstep : cB;
        for (int t = 0; t < nt; t += 2) {
            const bool last = (t == nt - 2);
            const char* a1 = cA + (size_t)(t + 1) * kstep;
            const char* a2 = last ? nA : cA + (size_t)(t + 2) * kstep; const char* b2 = last ? nB : cB + (size_t)(t + 2) * kstep;
            const char* a3 = a2 + kstep; const char* b3 = b2 + kstep;
            if constexpr (SP2) {
            PG8_LDB(B0, 0, 0); PG8_LDB(B1, 0, 1); PG8_SCHED; PG8_LDA(At, 0, 0); PG8_STAGE(PG8_SA(1, 1), a1 + hstep, voffA);
            PG8_WAIT_V(8); PG8_WAIT_L(0); PG8_BAR; PG8_MMA(0, 0, At, B0); PG8_MMA(0, 1, At, B1); PG8_BAR; PG8_SCHED;
            PG8_LDA(At, 0, 1); PG8_STAGE(PG8_SB(0, 0), b2, voffB); PG8_STAGE(PG8_SB(0, 1), b2 + hstep, voffB); PG8_STAGE(PG8_SA(0, 0), a2, voffA);
            PG8_WAIT_V(8); PG8_WAIT_L(0); PG8_BAR; PG8_MMA(1, 0, At, B0); PG8_MMA(1, 1, At, B1); PG8_BAR; PG8_SCHED;
            PG8_LDB(B0, 1, 0); PG8_LDB(B1, 1, 1); PG8_SCHED; PG8_LDA(At, 1, 0); PG8_STAGE(PG8_SA(0, 1), a2 + hstep, voffA);
            PG8_WAIT_V(8); PG8_WAIT_L(0); PG8_BAR; PG8_MMA(0, 0, At, B0); PG8_MMA(0, 1, At, B1); PG8_BAR; PG8_SCHED;
            PG8_LDA(At, 1, 1); PG8_STAGE(PG8_SB(1, 0), b3, voffB); PG8_STAGE(PG8_SB(1, 1), b3 + hstep, voffB); PG8_STAGE(PG8_SA(1, 0), a3, voffA);
            PG8_WAIT_V(8); PG8_WAIT_L(0); PG8_BAR; PG8_MMA(1, 0, At, B0); PG8_MMA(1, 1, At, B1); PG8_BAR; PG8_SCHED;
            } else {
            PG8_LDB(B0, 0, 0); PG8_SCHED; PG8_LDA(At, 0, 0); PG8_STAGE(PG8_SA(1, 1), a1 + hstep, voffA);
            PG8_WAIT_L(8); PG8_BAR; PG8_WAIT_L(0); PG8_MMA(0, 0, At, B0); PG8_BAR; PG8_SCHED;
            PG8_LDB(B1, 0, 1); PG8_STAGE(PG8_SB(0, 0), b2, voffB);
            PG8_BAR; PG8_WAIT_L(0); PG8_MMA(0, 1, At, B1); PG8_BAR;
            PG8_LDA(At, 0, 1); PG8_STAGE(PG8_SA(0, 0), a2, voffA);
            PG8_BAR; PG8_WAIT_L(0); PG8_MMA(1, 0, At, B0); PG8_BAR; PG8_SCHED;
            PG8_STAGE(PG8_SB(0, 1), b2 + hstep, voffB);
            PG8_WAIT_V(6); PG8_BAR; PG8_MMA(1, 1, At, B1); PG8_BAR;
            PG8_LDB(B0, 1, 0); PG8_SCHED; PG8_LDA(At, 1, 0); PG8_STAGE(PG8_SA(0, 1), a2 + hstep, voffA);
            PG8_WAIT_L(8); PG8_BAR; PG8_WAIT_L(0); PG8_MMA(0, 0, At, B0); PG8_BAR; PG8_SCHED;
            PG8_LDB(B1, 1, 1); PG8_STAGE(PG8_SB(1, 0), b3, voffB);
            PG8_BAR; PG8_WAIT_L(0); PG8_MMA(0, 1, At, B1); PG8_BAR;
            PG8_LDA(At, 1, 1); PG8_STAGE(PG8_SA(1, 0), a3, voffA);
            PG8_BAR; PG8_WAIT_L(0); PG8_MMA(1, 0, At, B0); PG8_BAR; PG8_SCHED;
            PG8_STAGE(PG8_SB(1, 1), b3 + hstep, voffB);
            PG8_WAIT_V(6); PG8_BAR; PG8_MMA(1, 1, At, B1); PG8_BAR;
            }
        }
        if constexpr (ALIGN_EPI) { if (wr == 0) PG8_BAR; }
        E(acc, cur, wr, wc, fr, fq);
        if (!has_next) break;
#pragma unroll
        for (int a = 0; a < 2; ++a)
#pragma unroll
            for (int b = 0; b < 2; ++b)
#pragma unroll
                for (int m = 0; m < 4; ++m)
#pragma unroll
                    for (int n = 0; n < 2; ++n) acc[a][b][m][n] = (f32x4){0.f, 0.f, 0.f, 0.f};
        cur = nxt; cA = nA; cB = nB; ++ui;
        if constexpr (ALIGN_EPI) { if (wr == 1) PG8_BAR; }
    }
    PG8_WAIT_V(0);
    if constexpr (!ALIGN_EPI) { if (wr == 0) PG8_BAR; }
    PG8_BAR;
#undef PG8_SA
#undef PG8_SB
#undef PG8_STAGE
#undef PG8_LDA
#undef PG8_LDB
#undef PG8_MMA
#undef PG8_WAIT_V
#undef PG8_WAIT_L
#undef PG8_BAR
#undef PG8_SCHED
}
}
using pg8::Unit;

#define EPI_ROWS_BEGIN _Pragma("unroll") for (int ai = 0; ai < 2; ++ai) _Pragma("unroll") for (int m = 0; m < 4; ++m) { const int row = u.pm * 256 + ai * 128 + wr * 64 + m * 16 + fr;
#define EPI_COLS_BEGIN _Pragma("unroll") for (int bj = 0; bj < 2; ++bj) { const int col = u.pn * 256 + bj * 128 + wc * 32 + 8 * fq; f32x4 v0 = acc[ai][bj][m][0], v1 = acc[ai][bj][m][1];
#define EPI_END } asm volatile("" ::: "memory"); }

struct EpiIn {
    static constexpr bool PERM = true;
    const float* ss; bf16_t *QA, *KP, *KS, *VTP, *VTS, *QKVB, *Z, *GA, *GB; float* BA;
    float *okp, *ovp, *oks, *ovs, *ogcp, *ogcs;
    __device__ __forceinline__ void operator()(const f32x4 (&acc)[2][2][4][2], const Unit& u, int wr, int wc, int fr, int fq) const {
        const int pn = u.pn;
        EPI_ROWS_BEGIN
            const float rs = rsqrtf(ss16(ss + (size_t)row * 16) * (1.f / 1024.f) + EPS);
            const bool samp = row >= TP; const int sidx = row - TP, sb = sidx >> 6, st = sidx & 63;
            EPI_COLS_BEGIN
                v0 = v0 * rs; v1 = v1 * rs;
                if (pn < 4) { st_bf8(QA + (size_t)row * 1024 + col, v0 * QSCALE, v1 * QSCALE); }
                else if (pn < 8) { const int c = col - 1024;
                    bf16_t* kb = samp ? KS + ((size_t)(sb * KVS + PAST + st)) * 1024 + c : KP + (size_t)row * 1024 + c; st_bf8(kb, v0, v1);
                    float* ko = samp ? oks + (size_t)sidx * 1024 + c : okp + (size_t)row * 1024 + c; st_f8(ko, v0, v1); }
                else if (pn < 12) { const int c = col - 2048;
                    float* vo = samp ? ovs + (size_t)sidx * 1024 + c : ovp + (size_t)row * 1024 + c; st_f8(vo, v0, v1);
                    bf16_t* vb = samp ? VTS + ((size_t)(sb * 1024 + c)) * KVS + PAST + st : VTP + (size_t)c * TP + row;
                    const size_t vp = samp ? (size_t)KVS : (size_t)TP;
#pragma unroll
                    for (int j = 0; j < 4; ++j) { vb[(size_t)j * vp] = (bf16_t)f2bf(v0[j]); vb[(size_t)(j + 4) * vp] = (bf16_t)f2bf(v1[j]); } }
                else if (pn < 24) { const int c = col - 3072; st_bf8(QKVB + (size_t)row * 3072 + c, v0, v1);
                    if (!samp && row >= TP - 3) st_f8(ogcp + (size_t)(row - (TP - 3)) * 3072 + c, v0, v1);
                    if (samp && st >= 61) st_f8(ogcs + (size_t)(sb * 3 + st - 61) * 3072 + c, v0, v1); }
                else if (pn < 28) { st_bf8(Z + (size_t)row * 1024 + (col - 6144), v0, v1); }
                else if (pn < 36) { bf16_t* gp = (pn < 32 ? GA + (col - 7168) : GB + (col - 8192)) + (size_t)row * 1024;
#pragma unroll
                    for (int j = 0; j < 4; ++j) { v0[j] = sigmoidf_(v0[j]); v1[j] = sigmoidf_(v1[j]); }
                    st_bf8(gp, v0, v1); }
                else { const int c = col - 9216; if (c < 16) st_f8(BA + (size_t)row * 16 + c, v0, v1); }
        EPI_END
    }
};
struct EpiGateA {
    static constexpr bool PERM = true;
    const bf16_t* G; float* MG;
    __device__ __forceinline__ void operator()(const f32x4 (&acc)[2][2][4][2], const Unit& u, int wr, int wc, int fr, int fq) const {
        EPI_ROWS_BEGIN EPI_COLS_BEGIN
            const size_t o = (size_t)row * 1024 + col; const u32x4 g = *(const u32x4*)(G + o);
            v0[0] *= bflo(g.x); v0[1] *= bfhi(g.x); v0[2] *= bflo(g.y); v0[3] *= bfhi(g.y); v1[0] *= bflo(g.z); v1[1] *= bfhi(g.z); v1[2] *= bflo(g.w); v1[3] *= bfhi(g.w);
            st_f8(MG + o, v0, v1);
        EPI_END
    }
};
struct EpiGateB {
    static constexpr bool PERM = true;
    const bf16_t* G; const float* MG; bf16_t* OUT;
    __device__ __forceinline__ void operator()(const f32x4 (&acc)[2][2][4][2], const Unit& u, int wr, int wc, int fr, int fq) const {
        EPI_ROWS_BEGIN EPI_COLS_BEGIN
            const size_t o = (size_t)row * 1024 + col; const u32x4 g = *(const u32x4*)(G + o);
            const f32x4 m0 = *(const f32x4*)(MG + o), m1 = *(const f32x4*)(MG + o + 4);
            v0[0] = m0[0] + v0[0] * bflo(g.x); v0[1] = m0[1] + v0[1] * bfhi(g.x); v0[2] = m0[2] + v0[2] * bflo(g.y); v0[3] = m0[3] + v0[3] * bfhi(g.y);
            v1[0] = m1[0] + v1[0] * bflo(g.z); v1[1] = m1[1] + v1[1] * bfhi(g.z); v1[2] = m1[2] + v1[2] * bflo(g.w); v1[3] = m1[3] + v1[3] * bfhi(g.w);
            st_bf8(OUT + o, v0, v1);
        EPI_END
    }
};
struct EpiRes {
    static constexpr bool PERM = true;
    float* X; const float* g; bf16_t* XN; float* ssout;
    __device__ __forceinline__ void operator()(const f32x4 (&acc)[2][2][4][2], const Unit& u, int wr, int wc, int fr, int fq) const {
        EPI_ROWS_BEGIN
            float s = 0.f;
            EPI_COLS_BEGIN
                const size_t o = (size_t)row * 1024 + col;
                v0 = v0 + *(const f32x4*)(X + o); v1 = v1 + *(const f32x4*)(X + o + 4);
                st_f8(X + o, v0, v1);
                s += (v0[0] * v0[0] + v0[1] * v0[1]) + (v0[2] * v0[2] + v0[3] * v0[3]) + (v1[0] * v1[0] + v1[1] * v1[1]) + (v1[2] * v1[2] + v1[3] * v1[3]);
                const f32x4 g0 = *(const f32x4*)(g + col), g1 = *(const f32x4*)(g + col + 4);
                st_bf8(XN + o, v0 * g0, v1 * g1);
            }
            s += __shfl_xor(s, 16); s += __shfl_xor(s, 32);
            if (fq == 0) ssout[(size_t)row * 16 + u.pn * 4 + wc] = s;
            asm volatile("" ::: "memory");
        }
    }
};
struct EpiUp {
    static constexpr bool PERM = true;
    const float* ss; bf16_t* U; float *ofcp, *ofcs;
    __device__ __forceinline__ void operator()(const f32x4 (&acc)[2][2][4][2], const Unit& u, int wr, int wc, int fr, int fq) const {
        EPI_ROWS_BEGIN
            const float rs = rsqrtf(ss16(ss + (size_t)row * 16) * (1.f / 1024.f) + EPS);
            const bool samp = row >= TP; const int sidx = row - TP, sb = sidx >> 6, st = sidx & 63;
            EPI_COLS_BEGIN
                v0 = v0 * rs; v1 = v1 * rs;
                st_bf8(U + (size_t)row * FF2 + col, v0, v1);
                if (!samp && row >= TP - 2) st_f8(ofcp + (size_t)(row - (TP - 2)) * FF2 + col, v0, v1);
                if (samp && st >= 62) st_f8(ofcs + (size_t)(sb * 2 + st - 62) * FF2 + col, v0, v1);
        EPI_END
    }
};

struct Params { const float* in[27]; float* out; unsigned char* ws; };

#define INP(i) (p.in[i])
__device__ __forceinline__ float uni(float v) { return __builtin_bit_cast(float, __builtin_amdgcn_readfirstlane(__builtin_bit_cast(int, v))); }
__device__ __forceinline__ void transpose_item(const float* src, size_t sp, bf16_t* dst, size_t dp, float* scr, int lane) {
#pragma unroll 8
    for (int i = 0; i < 32; ++i) { const int kk = 2 * i + (lane >> 5); scr[kk * 33 + (lane & 31)] = src[(size_t)kk * sp + (lane & 31)]; }
    __builtin_amdgcn_s_waitcnt(0); asm volatile("" ::: "memory");
    const int c = lane & 7;
#pragma unroll
    for (int j = 0; j < 4; ++j) { const int n = (lane >> 3) + 8 * j; const float* s = scr + (8 * c) * 33 + n;
        u32x4 o; o.x = pk2(s[0 * 33], s[1 * 33]); o.y = pk2(s[2 * 33], s[3 * 33]); o.z = pk2(s[4 * 33], s[5 * 33]); o.w = pk2(s[6 * 33], s[7 * 33]);
        *(u32x4*)(dst + (size_t)n * dp + 8 * c) = o; }
    __builtin_amdgcn_s_waitcnt(0); asm volatile("" ::: "memory");
}

constexpr int AT_SLOT = 16384, AT_Q = 4 * AT_SLOT, AT_QW = 32 * 272;
__device__ __forceinline__ void attn_unit(unsigned char* lds, const bf16_t* Qg, const bf16_t* Kg, const bf16_t* VTg, size_t vt_pitch, bf16_t* Og,
                                          int nactive, int qpos0, int ntiles, float sl2, const float* lamp, const float* subg, int wave_s, const unsigned* kmax2p) {
    const int tid = fresh_tid(wave_s);
    const int lane = tid & 63, wave = wave_s, q = lane & 31, hi = lane >> 5;
    const bool active = wave < nactive;
    const int qpos = qpos0 + 32 * wave + q;
    const int tv = active ? ((qpos0 + 32 * wave) >> 6) : -1;
    f32x16 O1[4], O2[4];
#pragma unroll
    for (int nb = 0; nb < 4; ++nb) { O1[nb] = (f32x16){}; O2[nb] = (f32x16){}; }
    float m1 = 0.f, m2 = 0.f, l1 = 0.f, l2 = 0.f;
    unsigned koff, voff;
    { const int kr = 4 * wave + (lane >> 4), kc = (lane & 15) ^ (kr & 15); koff = (unsigned)(kr * 1024 + kc * 8);
      const int vr = 16 * wave + (lane >> 2), vcx = (lane & 3) ^ ((vr >> 2) & 3); voff = (unsigned)(vr * (int)vt_pitch + vcx * 8); }
    LAS unsigned char* lds3 = (LAS unsigned char*)lds;
    const int nhalf = 2 * ntiles;
#define AT_DMA(u_) do { const int uu_ = (u_) < nhalf ? nhalf - 1 - (u_) : 0; const int sl_ = (u_) & 3; \
        __builtin_amdgcn_global_load_lds((const unsigned*)(Kg + (size_t)(koff + 32768u * (unsigned)uu_)), (LAS unsigned*)(lds3 + sl_ * AT_SLOT + wave * 1024), 16, 0, 0); \
        __builtin_amdgcn_global_load_lds((const unsigned*)(VTg + (size_t)(voff + 32u * (unsigned)uu_)), (LAS unsigned*)(lds3 + sl_ * AT_SLOT + 8192 + wave * 1024), 16, 0, 0); } while (0)
    unsigned char* Qs = lds + AT_Q + wave * AT_QW;
    const int lpk0 = (((q & 15) ^ hi) * 16) + q * 256, lpv0 = q * 64 + ((q >> 2) & 3) * 16 + 8 * hi;
    const int qaddr = AT_Q + wave * AT_QW + q * 272 + hi * 16, qd = qpos - 4 * hi;
    __syncthreads();
    {
        if (active) {
#pragma unroll
            for (int k = 0; k < 8; ++k) { const int pc = lane + 64 * k, r = pc >> 4, ch = pc & 15; *(u32x4*)(Qs + r * 272 + ch * 16) = *(const u32x4*)(Qg + (size_t)(32 * wave + r) * 1024 + ch * 8); }
        }
        asm volatile("s_waitcnt vmcnt(0) lgkmcnt(0)" ::: "memory");
        AT_DMA(0); AT_DMA(1); AT_DMA(2);
    }
    float bq1 = 0.f, bq2 = 0.f;
    if (kmax2p && active) { float s1 = 0.f, s2 = 0.f;
#pragma unroll
        for (int ch = 0; ch < 16; ++ch) { const u32x4 w = *(const u32x4*)(lds + (qaddr - hi * 16) + ch * 16);
            const float a0 = bflo(w.x), a1 = bfhi(w.x), a2 = bflo(w.y), a3 = bfhi(w.y), a4 = bflo(w.z), a5 = bfhi(w.z), a6 = bflo(w.w), a7 = bfhi(w.w);
            const float ss = (a0 * a0 + a1 * a1) + (a2 * a2 + a3 * a3) + (a4 * a4 + a5 * a5) + (a6 * a6 + a7 * a7);
            if (ch < 8) s1 += ss; else s2 += ss; }
        bq1 = sqrtf(s1) * sqrtf(__uint_as_float(kmax2p[0])) * 1.01f + 1.f; bq2 = sqrtf(s2) * sqrtf(__uint_as_float(kmax2p[1])) * 1.01f + 1.f; }
    unsigned char* flg = lds + AT_Q + 8 * AT_QW;
    for (int v = 0; v < nhalf; ++v) { const int u = nhalf - 1 - v;
        asm volatile("s_waitcnt vmcnt(4) lgkmcnt(0)\n\ts_barrier" ::: "memory");
        if (kmax2p && v > 0) { const u32x2 fv = *(const u32x2*)(flg + ((v - 1) & 1) * 8);
            const unsigned fw = fv.x & fv.y;
            if (__builtin_amdgcn_readfirstlane(fw & (fw >> 8) & (fw >> 16) & (fw >> 24) & 1u)) break; }
        AT_DMA(v + 3);
        const unsigned char* Ks = lds + (v & 3) * AT_SLOT; const unsigned char* Vs = Ks + 8192;
        const int t = u >> 1;
        if (t <= tv) {
            int lpk = lpk0, lpv = lpv0; asm volatile("" : "+v"(lpk), "+v"(lpv));
            const unsigned char* Kl = Ks; const unsigned char* Vl = Vs;
            const bool diag = (t == tv);
            {
                const float dfl = (float)(32 * u - qd);
                bf16x8 PA[2], PB[2];
#pragma unroll
                for (int mp = 0; mp < 2; ++mp) {
                    f32x16 p0 = (f32x16){};
#pragma unroll
                    for (int ds = 0; ds < 4; ++ds) {
                        const bf16x8 qf = *(const bf16x8*)(lds + qaddr + (mp * 64 + ds * 16) * 2);
                        const bf16x8 a0 = *(const bf16x8*)(Kl + (lpk ^ ((mp * 8 + ds * 2) * 16)));
                        p0 = __builtin_amdgcn_mfma_f32_32x32x16_bf16(a0, qf, p0, 0, 0, 0);
                    }
                    const float mo = mp ? m2 : m1;
                    if (!diag) { const float cm = sl2 * dfl - mo;
#pragma unroll
                        for (int r = 0; r < 16; ++r) p0[r] = fmaf(sl2, (float)((r & 3) + 8 * (r >> 2)), p0[r]) + cm;
                    } else {
#pragma unroll
                        for (int r = 0; r < 16; ++r) p0[r] = p0[r] - sl2 * fabsf(dfl + (float)((r & 3) + 8 * (r >> 2))) - mo;
                    }
                    float mx = fmaxf(fmaxf(p0[0], p0[1]), p0[2]);
#pragma unroll
                    for (int r = 3; r < 15; r += 2) mx = fmaxf(fmaxf(mx, p0[r]), p0[r + 1]);
                    mx = fmaxf(mx, p0[15]);
                    { auto rr = __builtin_amdgcn_permlane32_swap(__float_as_uint(mx), __float_as_uint(mx), false, false); mx = fmaxf(__uint_as_float(rr[0]), __uint_as_float(rr[1])); }
                    const bool first = (u == 2 * tv + 1);
                    if (first || __any(mx > 8.f)) {
                        const float dl = first ? mx : fmaxf(mx, 0.f);
#pragma unroll
                        for (int r = 0; r < 16; ++r) p0[r] -= dl;
                        if (!first) { const float al = __builtin_amdgcn_exp2f(-dl);
                            if (mp == 0) { l1 *= al;
#pragma unroll
                                for (int nb = 0; nb < 4; ++nb) O1[nb] = O1[nb] * al; }
                            else { l2 *= al;
#pragma unroll
                                for (int nb = 0; nb < 4; ++nb) O2[nb] = O2[nb] * al; } }
                        if (mp == 0) m1 = mo + dl; else m2 = mo + dl;
                    }
                    float rsum = 0.f;
#pragma unroll
                    for (int r = 0; r < 16; ++r) { p0[r] = __builtin_amdgcn_exp2f(p0[r]); rsum += p0[r]; }
                    if (mp == 0) { l1 += rsum; PA[0] = pack8(p0[0], p0[1], p0[2], p0[3], p0[4], p0[5], p0[6], p0[7]); PA[1] = pack8(p0[8], p0[9], p0[10], p0[11], p0[12], p0[13], p0[14], p0[15]); }
                    else { l2 += rsum; PB[0] = pack8(p0[0], p0[1], p0[2], p0[3], p0[4], p0[5], p0[6], p0[7]); PB[1] = pack8(p0[8], p0[9], p0[10], p0[11], p0[12], p0[13], p0[14], p0[15]); }
                }
#pragma unroll
                for (int nb = 0; nb < 4; ++nb) {
#pragma unroll
                    for (int jj = 0; jj < 2; ++jj) { const unsigned char* vp = Vl + nb * 2048;
                        const s16x4 lo = *(const s16x4*)(vp + (lpv ^ ((2 * jj) * 16))), hh = *(const s16x4*)(vp + (lpv ^ ((2 * jj + 1) * 16)));
                        const bf16x8 vf = (bf16x8){lo[0], lo[1], lo[2], lo[3], hh[0], hh[1], hh[2], hh[3]};
                        O1[nb] = __builtin_amdgcn_mfma_f32_32x32x16_bf16(vf, PA[jj], O1[nb], 0, 0, 0);
                        O2[nb] = __builtin_amdgcn_mfma_f32_32x32x16_bf16(vf, PB[jj], O2[nb], 0, 0, 0); }
                    asm volatile("" : "+v"(O1[nb]), "+v"(O2[nb])); __builtin_amdgcn_sched_barrier(0); }
                asm volatile("" ::: "memory");
            }
        }
        if (kmax2p) {
            bool negl = true;
            if (active) { const float dist = (float)(qd + 4 * hi - 32 * u + 1);
                negl = (u <= 2 * tv + 1) && (dist > 0.f) && (bq1 - sl2 * dist - m1 < -48.f) && (bq2 - sl2 * dist - m2 < -48.f); }
            const bool wv = __all(negl);
            if (lane == 0) flg[(v & 1) * 8 + wave] = wv ? 1 : 0;
        }
    }
#undef AT_DMA
    if (active) {
        const int tid2 = fresh_tid(wave_s);
        const int q = tid2 & 31, hi = (tid2 >> 5) & 1;
        l1 += __shfl_xor(l1, 32); l2 += __shfl_xor(l2, 32);
        const float lam = lamp[0], oscale = lamp[1];
        const float i1 = 1.f / l1, i2 = lam / l2; float ssq = 0.f;
#pragma unroll
        for (int nb = 0; nb < 4; ++nb)
#pragma unroll
            for (int r = 0; r < 16; ++r) { const float od = O1[nb][r] * i1 - O2[nb][r] * i2; O1[nb][r] = od; ssq += od * od; }
        ssq += __shfl_xor(ssq, 32);
        const float rn = rsqrtf(ssq * (1.f / 128.f) + EPS) * oscale;
        bf16_t* orow = Og + (size_t)(32 * wave + q) * 1024;
#pragma unroll
        for (int nb = 0; nb < 4; ++nb)
#pragma unroll
            for (int rg = 0; rg < 4; ++rg) { const int dv0 = 32 * nb + 8 * rg + 4 * hi; const f32x4 g = *(const f32x4*)(subg + dv0);
                u32x2 w; w.x = pk2(O1[nb][4 * rg] * rn * g[0], O1[nb][4 * rg + 1] * rn * g[1]); w.y = pk2(O1[nb][4 * rg + 2] * rn * g[2], O1[nb][4 * rg + 3] * rn * g[3]);
                *(u32x2*)(orow + dv0) = w; }
    }
    __syncthreads();
}

__device__ __forceinline__ void cache_conv_unit(unsigned char* lds, const Params& p, unsigned char* ws, int l, int b, int kvb, int wave_s) {
    const int tid = fresh_tid(wave_s); const int lane = tid & 63, wave = wave_s;
    const float* ck = p.in[2] + ((size_t)(l * 8 + b) * PAST + 64 * kvb) * 1024; const float* cv = p.in[3] + ((size_t)(l * 8 + b) * PAST + 64 * kvb) * 1024;
    bf16_t* KS = (bf16_t*)(ws + WS_KS) + ((size_t)b * KVS + 64 * kvb) * 1024; bf16_t* VTS = (bf16_t*)(ws + WS_VTS);
    __syncthreads();
#pragma unroll 4
    for (int k = 0; k < 16; ++k) { const size_t e = ((size_t)k * 512 + tid) * 8; const f32x4 a = *(const f32x4*)(ck + e), c4 = *(const f32x4*)(ck + e + 4); st_bf8(KS + e, a, c4); }
    float* scr = (float*)(lds + wave * 8448);
#pragma unroll 1
    for (int j = 0; j < 4; ++j) { const int it = wave * 4 + j, dvb = it & 3, hh = it >> 2;
        transpose_item(cv + hh * 128 + 32 * dvb, 1024, VTS + ((size_t)((b * 8 + hh) * 128 + 32 * dvb)) * KVS + 64 * kvb, KVS, scr, lane); }
    asm volatile("s_waitcnt vmcnt(0)" ::: "memory");
    __syncthreads();
    if (tid == 0) { __builtin_amdgcn_fence(__ATOMIC_RELEASE, "agent");
        __hip_atomic_fetch_add((unsigned*)(ws + WS_CTL) + 48 + l * 8 + b, 1u, __ATOMIC_RELAXED, __HIP_MEMORY_SCOPE_AGENT); }
}

constexpr int GP_LM = 0, GP_AT = 64 * 64 * 4, GP_SM = GP_AT + 64 * 65 * 4, GP_QC = GP_SM + 1024, GP_KC = GP_QC + 64 * 129 * 4, GP_VC = GP_KC + 64 * 129 * 4;
__device__ __forceinline__ void gdn_prep_unit(unsigned char* lds, const Params& p, int l, int ch, int h, int wave_s) {
    const int tid = fresh_tid(wave_s);
    const int lane = tid & 63, wave = wave_s;
    float* qc = (float*)(lds + GP_QC); float* kc = (float*)(lds + GP_KC); float* vc = (float*)(lds + GP_VC); float* Lm = (float*)(lds + GP_LM); float* AT = (float*)(lds + GP_AT);
    float* sG = (float*)(lds + GP_SM); float* sB = sG + 64; float* sRq = sG + 128; float* sRk = sG + 192;
    const bf16_t* QKVB = (const bf16_t*)(p.ws + WS_QKVB); const float* BA = (const float*)(p.ws + WS_BA);
    unsigned char* blob = p.ws + WS_GDNP + (size_t)(h * 264 + ch) * BLOB;
    const int m0 = ch * 64; const bool samp = ch >= 256; const int sb = ch - 256;
    __syncthreads();
    if (tid < 384) {
        const int part = tid >> 7, c = tid & 127;
        const int col = (part == 0 ? 2048 : (part == 1 ? 1024 : 0)) + h * 128 + c;
        float* dstc = (part == 0 ? vc : (part == 1 ? kc : qc)) + c;
        const float* cw = INP(14) + (size_t)l * 4 * 3072 + col;
        const float w0 = cw[0], w1 = cw[3072], w2 = cw[2 * 3072], w3 = cw[3 * 3072];
        float x3, x2, x1;
        if (samp) { const float* sc = INP(5) + ((size_t)(l * 8 + sb) * 3) * 3072 + col; x3 = sc[0]; x2 = sc[3072]; x1 = sc[2 * 3072]; }
        else if (ch == 0) { x3 = 0.f; x2 = 0.f; x1 = 0.f; }
        else { const bf16_t* pr = QKVB + (size_t)(m0 - 3) * 3072 + col; x3 = bf2f(pr[0]); x2 = bf2f(pr[3072]); x1 = bf2f(pr[2 * 3072]); }
        const bf16_t* xp = QKVB + (size_t)m0 * 3072 + col;
        bf16_t raw[64];
#pragma unroll
        for (int i = 0; i < 64; ++i) raw[i] = xp[(size_t)i * 3072];
#pragma unroll
        for (int i = 0; i < 64; ++i) {
            const float x0 = bf2f(raw[i]);
            float y = w0 * x3 + w1 * x2 + w2 * x1 + w3 * x0; y = siluf_(y);
            x3 = x2; x2 = x1; x1 = x0;
            dstc[i * 129] = y;
        }
    } else if (tid < 448) {
        const int i = tid - 384;
        const float braw = BA[(size_t)(m0 + i) * 16 + h], araw = BA[(size_t)(m0 + i) * 16 + 8 + h];
        const float xx = araw + INP(16)[l * 8 + h];
        const float sp = xx > 20.f ? xx : log1pf(__expf(xx));
        float G = -__expf(INP(15)[l * 8 + h]) * sp;
#pragma unroll
        for (int o = 1; o < 64; o <<= 1) { const float tt = __shfl_up(G, o); if (i >= o) G += tt; }
        sG[i] = G; sB[i] = sigmoidf_(braw);
    }
    __syncthreads();
    {
#pragma unroll
        for (int rr = 0; rr < 8; ++rr) { const int row = wave * 8 + rr;
            const float a = qc[row * 129 + lane], b = qc[row * 129 + 64 + lane], c2 = kc[row * 129 + lane], d2 = kc[row * 129 + 64 + lane];
            const float sq = wave_sum(a * a + b * b), sk = wave_sum(c2 * c2 + d2 * d2);
            if (lane == 0) { sRq[row] = rsqrtf(sq + EPS) * 0.08838834764831845f; sRk[row] = rsqrtf(sk + EPS); } }
    }
    __syncthreads();
    {
        const int fi = lane & 15, fk = lane >> 4;
#pragma unroll 1
        for (int tt = 0; tt < 4; ++tt) {
            const int tile = wave * 4 + tt, isq = tile >> 4, ti = (tile >> 2) & 3, tj = tile & 3;
            if (ti < tj) continue;
            const float* X = isq ? qc : kc;
            f32x4 d = (f32x4){0.f, 0.f, 0.f, 0.f};
#pragma unroll 8
            for (int s = 0; s < 32; ++s) {
                const float a = X[(16 * ti + fi) * 129 + 4 * s + fk], b = kc[(16 * tj + fi) * 129 + 4 * s + fk];
                d = __builtin_amdgcn_mfma_f32_16x16x4f32(a, b, d, 0, 0, 0);
            }
            const int j = 16 * tj + fi; const float gj = sG[j], rkj = sRk[j];
#pragma unroll
            for (int r = 0; r < 4; ++r) { const int i = 16 * ti + 4 * fk + r; const float gi = sG[i];
                const float dec = __expf(fminf(gi - gj, 0.f));
                if (isq) AT[i * 65 + j] = (i >= j) ? sRq[i] * rkj * d[r] * dec : 0.f;
                else Lm[i * 64 + j] = (i > j) ? sB[i] * sRk[i] * rkj * d[r] * dec : 0.f; }
        }
        for (int e = tid; e < 64 * 64; e += 512) { const int i = e >> 6, j = e & 63; if ((i >> 4) < (j >> 4)) { Lm[i * 64 + j] = 0.f; AT[i * 65 + j] = 0.f; } }
    }
    __syncthreads();
    const float glast = sG[63];
    if (tid < 256) {
        float xr[64];
        if (tid < 128) {
#pragma unroll
            for (int i = 0; i < 64; ++i) xr[i] = vc[i * 129 + tid] * sB[i];
        } else {
#pragma unroll
            for (int i = 0; i < 64; ++i) xr[i] = kc[i * 129 + tid - 128] * sB[i] * sRk[i] * __expf(sG[i]);
        }
#pragma unroll
        for (int i = 1; i < 64; ++i) {
            float a0 = 0.f, a1 = 0.f, a2 = 0.f, a3 = 0.f;
#pragma unroll
            for (int j4 = 0; j4 < (i + 3) / 4; ++j4) { const f32x4 lv = *(const f32x4*)(Lm + i * 64 + 4 * j4);
                a0 += lv[0] * xr[4 * j4]; if (4 * j4 + 1 < i) a1 += lv[1] * xr[4 * j4 + 1]; if (4 * j4 + 2 < i) a2 += lv[2] * xr[4 * j4 + 2]; if (4 * j4 + 3 < i) a3 += lv[3] * xr[4 * j4 + 3]; }
            xr[i] -= (a0 + a1) + (a2 + a3);
        }
        if (tid < 128) {
            const int v = tid, w = v >> 5, n = v & 31; float* U = (float*)(blob + BLOB_U);
#pragma unroll
            for (int tile = 0; tile < 2; ++tile)
#pragma unroll
                for (int a8 = 0; a8 < 4; ++a8)
#pragma unroll
                    for (int hh = 0; hh < 2; ++hh) { const int c0 = 32 * tile + 8 * a8 + 4 * hh;
                        *(f32x4*)(U + ((size_t)((w * 2 + tile) * 64 + hh * 32 + n)) * 16 + 4 * a8) = (f32x4){xr[c0], xr[c0 + 1], xr[c0 + 2], xr[c0 + 3]}; }
        } else {
            const int k = tid - 128, s = k >> 4, kk = k & 15, hh = (kk >> 2) & 1, j = (kk & 3) + 4 * (kk >> 3); bf16_t* W = (bf16_t*)blob;
#pragma unroll
            for (int c = 0; c < 64; ++c) { const int i = c >> 5, mrow = c & 31; W[(size_t)(((i * 8 + s) * 64 + hh * 32 + mrow)) * 8 + j] = (bf16_t)f2bf(-xr[c]); }
        }
    } else {
        const int t2 = tid - 256;
#pragma unroll 1
        for (int pc = t2; pc < 1024; pc += 256) { const int f = pc >> 6, ll = pc & 63, i = f >> 3, s = f & 7, row = 32 * i + (ll & 31), hh = ll >> 5;
            const float sc = sRq[row] * __expf(sG[row]); float vv[8];
#pragma unroll
            for (int j = 0; j < 8; ++j) vv[j] = qc[row * 129 + 16 * s + (j & 3) + 8 * (j >> 2) + 4 * hh] * sc;
            *(bf16x8*)(blob + 16384 + (size_t)pc * 16) = pack8(vv[0], vv[1], vv[2], vv[3], vv[4], vv[5], vv[6], vv[7]); }
#pragma unroll 1
        for (int pc = t2; pc < 512; pc += 256) { const int f = pc >> 6, ll = pc & 63, i = f >> 2, s = f & 3, row = 32 * i + (ll & 31), hh = ll >> 5; float vv[8];
#pragma unroll
            for (int j = 0; j < 8; ++j) vv[j] = AT[row * 65 + 16 * s + (j & 3) + 8 * (j >> 2) + 4 * hh];
            *(bf16x8*)(blob + 32768 + (size_t)pc * 16) = pack8(vv[0], vv[1], vv[2], vv[3], vv[4], vv[5], vv[6], vv[7]); }
#pragma unroll 1
        for (int pc = t2; pc < 1024; pc += 256) { const int f = pc >> 6, ll = pc & 63, kt = f >> 2, s = f & 3, krow = 32 * kt + (ll & 31), hh = ll >> 5; float vv[8];
#pragma unroll
            for (int j = 0; j < 8; ++j) { const int c = 16 * s + (j & 3) + 8 * (j >> 2) + 4 * hh; vv[j] = kc[c * 129 + krow] * sRk[c] * __expf(glast - sG[c]); }
            *(bf16x8*)(blob + 40960 + (size_t)pc * 16) = pack8(vv[0], vv[1], vv[2], vv[3], vv[4], vv[5], vv[6], vv[7]); }
        if (t2 == 0) *(float*)(blob + BLOB_EG) = __expf(glast);
    }
    asm volatile("s_waitcnt vmcnt(0)" ::: "memory");
    __syncthreads();
    if (tid == 0) { __builtin_amdgcn_fence(__ATOMIC_RELEASE, "agent");
        __hip_atomic_store((unsigned*)(p.ws + WS_CTL) + 8192 + l * 2112 + h * 264 + ch, 1u, __ATOMIC_RELAXED, __HIP_MEMORY_SCOPE_AGENT); }
}

constexpr int SC_OT = 2 * BLOB_A;
__device__ __forceinline__ void gdn_scan_unit(unsigned char* lds, unsigned char* ws, const float* gn, int ch0, int nsteps, int h, const float* S0, float* Sout, int wave_s, unsigned* rdy) {
    const int tid = fresh_tid(wave_s);
    const int lane = tid & 63, wave = wave_s, n = lane & 31, hi = lane >> 5;
    const unsigned char* blob0 = ws + WS_GDNP + (size_t)(h * 264 + ch0) * BLOB;
    const size_t bstep = (size_t)BLOB;
    float* ot = (float*)(lds + SC_OT);
    const bf16_t* Z = (const bf16_t*)(ws + WS_Z); bf16_t* OB = (bf16_t*)(ws + WS_OB);
#define SC_WAITRDY(a_, b_) do { if (tid == 0) { for (int k_ = (a_); k_ < (b_); ++k_) { unsigned sp_ = 0; \
            while (__hip_atomic_load(rdy + k_, __ATOMIC_RELAXED, __HIP_MEMORY_SCOPE_AGENT) == 0u) { __builtin_amdgcn_s_sleep(8); if (++sp_ > (1u << 24)) break; } } } \
        asm volatile("s_waitcnt vmcnt(0) lgkmcnt(0)" ::: "memory"); __builtin_amdgcn_s_barrier(); asm volatile("" ::: "memory"); \
        __builtin_amdgcn_fence(__ATOMIC_ACQUIRE, "agent"); } while (0)
    __syncthreads();
    SC_WAITRDY(0, nsteps < 32 ? nsteps : 32);
    LAS unsigned char* lds3 = (LAS unsigned char*)lds;
#define SC_DMA(src_, stage_) do { _Pragma("unroll") for (int k_ = 0; k_ < 14; ++k_) \
        __builtin_amdgcn_global_load_lds((const unsigned*)((src_) + (size_t)(((wave - 4) * 14 + k_) * 1024) + (unsigned)(lane * 16)), \
            (LAS unsigned*)(lds3 + (stage_) * BLOB_A + ((wave - 4) * 14 + k_) * 1024), 16, 0, 0); } while (0)
#define SC_BS(s) pack8(S[(s) >> 1][8 * ((s) & 1)], S[(s) >> 1][8 * ((s) & 1) + 1], S[(s) >> 1][8 * ((s) & 1) + 2], S[(s) >> 1][8 * ((s) & 1) + 3], S[(s) >> 1][8 * ((s) & 1) + 4], S[(s) >> 1][8 * ((s) & 1) + 5], S[(s) >> 1][8 * ((s) & 1) + 6], S[(s) >> 1][8 * ((s) & 1) + 7])
#define SC_NORM(cc, zz) do { const size_t mb_ = ((size_t)(ch0 + (cc)) * 64) * 1024 + h * 128; \
        float ssq_ = 0.f; \
        _Pragma("unroll") for (int k = 0; k < 8; ++k) { const f32x4 t4 = *(const f32x4*)(ot + nrow * 132 + 32 * nqd + 4 * k); ssq_ += (t4[0] * t4[0] + t4[1] * t4[1]) + (t4[2] * t4[2] + t4[3] * t4[3]); } \
        ssq_ += __shfl_xor(ssq_, 1); ssq_ += __shfl_xor(ssq_, 2); \
        const float rstd = rsqrtf(ssq_ * (1.f / 128.f) + EPS); bf16_t* op = OB + mb_ + nmoff; \
        _Pragma("unroll") for (int k = 0; k < 4; ++k) { const float* gg = gq + 8 * k; \
            const f32x4 oa = *(const f32x4*)(ot + nrow * 132 + 32 * nqd + 8 * k), ob = *(const f32x4*)(ot + nrow * 132 + 32 * nqd + 8 * k + 4); \
            u32x4 w; w.x = pk2(oa[0] * rstd * gg[0] * siluf_(bflo(zz[k].x)), oa[1] * rstd * gg[1] * siluf_(bfhi(zz[k].x))); \
            w.y = pk2(oa[2] * rstd * gg[2] * siluf_(bflo(zz[k].y)), oa[3] * rstd * gg[3] * siluf_(bfhi(zz[k].y))); \
            w.z = pk2(ob[0] * rstd * gg[4] * siluf_(bflo(zz[k].z)), ob[1] * rstd * gg[5] * siluf_(bfhi(zz[k].z))); \
            w.w = pk2(ob[2] * rstd * gg[6] * siluf_(bflo(zz[k].w)), ob[3] * rstd * gg[7] * siluf_(bfhi(zz[k].w))); \
            *(GAS u32x4*)(op + 8 * k) = w; } } while (0)
    if (wave < 4) {
        f32x16 S[4], Ua[2]; float ega = 0.f;
#pragma unroll
        for (int kt = 0; kt < 4; ++kt)
#pragma unroll
            for (int r = 0; r < 16; ++r) S[kt][r] = S0 ? S0[(size_t)(32 * kt + crow(r, hi)) * 128 + 32 * wave + n] : 0.f;
#define SC_ULD(UR, EG, cc) do { const unsigned char* ub_ = blob0 + (size_t)(cc) * bstep; \
            _Pragma("unroll") for (int i = 0; i < 2; ++i) UR[i] = *(const GAS f32x16*)(ub_ + (size_t)(BLOB_U + (wave * 2 + i) * 4096) + (unsigned)(lane * 64)); \
            EG = *(const GAS float*)(ub_ + BLOB_EG); } while (0)
#define SC_LDP12(F, s_) do { F[0] = *(const bf16x8*)(Al + ((s_)) * 1024); F[1] = *(const bf16x8*)(Al + (8 + (s_)) * 1024); F[2] = *(const bf16x8*)(Al + 16384 + ((s_)) * 1024); F[3] = *(const bf16x8*)(Al + 16384 + (8 + (s_)) * 1024); } while (0)
#define SC_LDROW(F, base_, f0_) do { _Pragma("unroll") for (int j_ = 0; j_ < 4; ++j_) F[j_] = *(const bf16x8*)(Al + (base_) + ((f0_) + j_) * 1024); } while (0)
#define SC_G12(s_, CUR, NXT, LOADNEXT) do { LOADNEXT; __builtin_amdgcn_sched_barrier(0); { const bf16x8 bs = SC_BS(s_); \
            vn[0] = __builtin_amdgcn_mfma_f32_32x32x16_bf16(CUR[0], bs, vn[0], 0, 0, 0); vn[1] = __builtin_amdgcn_mfma_f32_32x32x16_bf16(CUR[1], bs, vn[1], 0, 0, 0); \
            o[0] = __builtin_amdgcn_mfma_f32_32x32x16_bf16(CUR[2], bs, o[0], 0, 0, 0); o[1] = __builtin_amdgcn_mfma_f32_32x32x16_bf16(CUR[3], bs, o[1], 0, 0, 0); } \
            asm volatile("" : "+v"(vn[0]), "+v"(vn[1]), "+v"(o[0]), "+v"(o[1])); __builtin_amdgcn_sched_barrier(0); } while (0)
#define SC_GROW(ACC, CUR, NXT, LOADNEXT) do { LOADNEXT; __builtin_amdgcn_sched_barrier(0); \
            _Pragma("unroll") for (int j_ = 0; j_ < 4; ++j_) ACC = __builtin_amdgcn_mfma_f32_32x32x16_bf16(CUR[j_], bV[j_], ACC, 0, 0, 0); \
            asm volatile("" : "+v"(ACC)); __builtin_amdgcn_sched_barrier(0); } while (0)
#define SC_CSTEP(c, UR, EG) do { \
            const unsigned char* A = lds + ((c) & 1) * BLOB_A; \
            const float eg = EG; \
            f32x16 vn[2]; vn[0] = UR[0]; vn[1] = UR[1]; \
            if ((c) + 1 < nsteps) SC_ULD(UR, EG, (c) + 1); \
              \
            const unsigned char* Al = A + lane * 16; \
            bf16x8 F0[4], F1[4]; f32x16 o[2]; o[0] = (f32x16){}; o[1] = (f32x16){}; \
            SC_LDP12(F0, 0); \
            SC_G12(0, F0, F1, SC_LDP12(F1, 1)); SC_G12(1, F1, F0, SC_LDP12(F0, 2)); SC_G12(2, F0, F1, SC_LDP12(F1, 3)); SC_G12(3, F1, F0, SC_LDP12(F0, 4)); \
            SC_G12(4, F0, F1, SC_LDP12(F1, 5)); SC_G12(5, F1, F0, SC_LDP12(F0, 6)); SC_G12(6, F0, F1, SC_LDP12(F1, 7)); SC_G12(7, F1, F0, SC_LDROW(F0, 32768, 0)); \
            bf16x8 bV[4]; \
            _Pragma("unroll") for (int s = 0; s < 4; ++s) { const int i = s >> 1, b = 8 * (s & 1); \
                bV[s] = pack8(vn[i][b], vn[i][b + 1], vn[i][b + 2], vn[i][b + 3], vn[i][b + 4], vn[i][b + 5], vn[i][b + 6], vn[i][b + 7]); } \
            SC_GROW(o[0], F0, F1, SC_LDROW(F1, 32768, 4)); \
            SC_GROW(o[1], F1, F0, SC_LDROW(F0, 40960, 0)); \
            S[0] = S[0] * eg; SC_GROW(S[0], F0, F1, SC_LDROW(F1, 40960, 4)); \
            S[1] = S[1] * eg; SC_GROW(S[1], F1, F0, SC_LDROW(F0, 40960, 8)); \
            S[2] = S[2] * eg; SC_GROW(S[2], F0, F1, SC_LDROW(F1, 40960, 12)); \
            S[3] = S[3] * eg; SC_GROW(S[3], F1, F0, (void)0); \
            asm volatile("s_waitcnt lgkmcnt(0)\n\ts_barrier" ::: "memory");     \
            _Pragma("unroll") for (int i = 0; i < 2; ++i) \
                _Pragma("unroll") for (int r = 0; r < 16; ++r) ot[(32 * i + crow(r, hi)) * 132 + 32 * wave + n] = o[i][r]; \
            asm volatile("s_waitcnt lgkmcnt(0)\n\ts_barrier" ::: "memory");     \
        } while (0)
        SC_ULD(Ua, ega, 0);
        __syncthreads();
        for (int c = 0; c < nsteps; ++c) { if ((c & 31) == 16 && c + 16 < nsteps) SC_WAITRDY(c + 16, c + 48 < nsteps ? c + 48 : nsteps); SC_CSTEP(c, Ua, ega); }
#undef SC_ULD
#undef SC_CSTEP
        { const int t3 = fresh_tid(wave_s), n3 = t3 & 31, hi3 = (t3 >> 5) & 1;
#pragma unroll
        for (int kt = 0; kt < 4; ++kt)
#pragma unroll
            for (int r = 0; r < 16; ++r) Sout[(size_t)(32 * kt + crow(r, hi3)) * 128 + 32 * wave + n3] = S[kt][r]; }
    } else {
        const int lt = tid - 256, nrow = lt >> 2, nqd = lt & 3; const unsigned nmoff = (unsigned)(nrow * 1024 + 32 * nqd);
        u32x4 zn[4];
        float* gq = (float*)(lds + SC_OT + 64 * 132 * 4) + 32 * nqd;
        if (lt < 128) ((float*)(lds + SC_OT + 64 * 132 * 4))[lt] = gn[lt];
        u32x4 pa[14], pb[14];
        const unsigned lo16 = (unsigned)lt * 16u;
#define SC_LD(dst, cc) do { const unsigned char* sb_ = blob0 + (size_t)(cc) * bstep; _Pragma("unroll") for (int k_ = 0; k_ < 14; ++k_) dst[k_] = *(const GAS u32x4*)(sb_ + (size_t)(4096 * k_) + lo16); } while (0)
#define SC_ST(src, stage_) do { unsigned char* sd_ = lds + (stage_) * BLOB_A; _Pragma("unroll") for (int k_ = 0; k_ < 14; ++k_) *(u32x4*)(sd_ + lo16 + 4096 * k_) = src[k_]; } while (0)
#define SC_STEP(c, PREG) do { \
            u32x4 zc[4]; \
            _Pragma("unroll") for (int k = 0; k < 4; ++k) zc[k] = zn[k]; \
            { const bf16_t* zp = Z + ((size_t)(ch0 + (c)) * 64) * 1024 + h * 128 + nmoff; \
              _Pragma("unroll") for (int k = 0; k < 4; ++k) zn[k] = *(const GAS u32x4*)(zp + 8 * k); } \
            if ((c) + 1 < nsteps) SC_ST(PREG, ((c) + 1) & 1);          \
            if ((c) + 3 < nsteps) SC_LD(PREG, (c) + 3);                 \
            if ((c) > 0) SC_NORM((c) - 1, zc); \
            asm volatile("s_waitcnt lgkmcnt(0)\n\ts_barrier" ::: "memory");     \
            asm volatile("s_waitcnt lgkmcnt(0)\n\ts_barrier" ::: "memory");     \
        } while (0)
        SC_DMA(blob0, 0);
        if (1 < nsteps) SC_LD(pa, 1);
        if (2 < nsteps) SC_LD(pb, 2);
        __syncthreads();
        for (int c = 0; c < nsteps; c += 8) {
            if ((c & 31) == 16 && c + 16 < nsteps) SC_WAITRDY(c + 16, c + 48 < nsteps ? c + 48 : nsteps);
            SC_STEP(c, pa);
            if (c + 1 < nsteps) SC_STEP(c + 1, pb);
            if (c + 2 < nsteps) SC_STEP(c + 2, pa);
            if (c + 3 < nsteps) SC_STEP(c + 3, pb);
            if (c + 4 < nsteps) SC_STEP(c + 4, pa);
            if (c + 5 < nsteps) SC_STEP(c + 5, pb);
            if (c + 6 < nsteps) SC_STEP(c + 6, pa);
            if (c + 7 < nsteps) SC_STEP(c + 7, pb);
        }
#undef SC_LD
#undef SC_ST
#undef SC_STEP
        SC_NORM(nsteps - 1, zn);
    }
    __syncthreads();
#undef SC_WAITRDY
#undef SC_DMA
#undef SC_BS
#undef SC_NORM
}


#define XB_TMO      128
#define XB_XCNT(j)  (256  + 64 * (j))
#define XB_XSUB(j)  (1280 + 64 * (j))
#define XB_XGEN(j)  (2304 + 64 * (j))
#define XB_TOP      3328
#define XB_TOPGEN   3392
#define XCD_BAR_WORDS 3456
#define XB_SPIN_CAP (1u << 18)
__device__ __forceinline__ unsigned xb_ld(unsigned* p)              { return __hip_atomic_load(p, __ATOMIC_RELAXED, __HIP_MEMORY_SCOPE_AGENT); }
__device__ __forceinline__ unsigned xb_add(unsigned* p, unsigned v) { return __hip_atomic_fetch_add(p, v, __ATOMIC_RELAXED, __HIP_MEMORY_SCOPE_AGENT); }
__device__ __forceinline__ unsigned xb_xcc_id() { return (unsigned)__builtin_amdgcn_s_getreg((3 << 11) | 20) & 0xFu; }
#define XB_SPIN(cond, bar) do { unsigned _sp = 0; while (cond) { __builtin_amdgcn_s_sleep(1); \
    if ((++_sp & 255u) == 0u) { if (xb_ld(&(bar)[XB_TMO])) break; if (_sp > XB_SPIN_CAP) { atomicAdd(&(bar)[XB_TMO], 1u); break; } } } } while (0)
struct XcdBarrier { unsigned* bar; unsigned x; volatile LAS unsigned* st; };
__device__ __forceinline__ XcdBarrier xcd_barrier_post(unsigned* bar, volatile LAS unsigned* st, bool leader) {
    XcdBarrier b; b.bar = bar; b.x = xb_xcc_id(); b.st = st;
    if (leader) (void)xb_add(&bar[XB_XCNT(b.x)], 1u);
    return b;
}
__device__ __forceinline__ void xcd_barrier_complete(unsigned* bar, unsigned x, unsigned& nloc, unsigned& nx) {
    const unsigned G = gridDim.x * gridDim.y * gridDim.z;
    unsigned sum, cnt, mine, sp = 0u;
    for (;;) {
        sum = 0u; cnt = 0u; mine = 0u;
#pragma unroll
        for (unsigned j = 0; j < 16; ++j) { const unsigned c = xb_ld(&bar[XB_XCNT(j)]); sum += c; cnt += (c > 0u) ? 1u : 0u; mine = (j == x) ? c : mine; }
        if (sum == G) break;
        __builtin_amdgcn_s_sleep(1);
        if ((++sp & 255u) == 0u) { if (xb_ld(&bar[XB_TMO])) break; if (sp > XB_SPIN_CAP) { atomicAdd(&bar[XB_TMO], 1u); break; } }
    }
    nloc = mine > 0u ? mine : 1u; nx = cnt > 0u ? cnt : 1u;
}
__device__ __forceinline__ void xcd_barrier(const XcdBarrier& b, bool leader) {
    asm volatile("s_waitcnt vmcnt(0)" ::: "memory");
    __syncthreads();
    if (leader) {
        unsigned* bar = b.bar;
        __builtin_amdgcn_s_waitcnt(0);
        unsigned nloc = b.st[0], nx = b.st[1];
        if (nloc == 0u) { xcd_barrier_complete(bar, b.x, nloc, nx); b.st[0] = nloc; b.st[1] = nx; }
        const unsigned old = xb_add(&bar[XB_XSUB(b.x)], 1u);
        const unsigned gen = old / nloc;
        if (old + 1u == (gen + 1u) * nloc) {
            __builtin_amdgcn_fence(__ATOMIC_RELEASE, "agent");
            asm volatile("s_waitcnt vmcnt(0)" ::: "memory");
            const unsigned og = xb_add(&bar[XB_TOP], 1u);
            const unsigned tg = og / nx;
            if (og + 1u == (tg + 1u) * nx) xb_add(&bar[XB_TOPGEN], 1u);
            else XB_SPIN(xb_ld(&bar[XB_TOPGEN]) == tg, bar);
            __builtin_amdgcn_fence(__ATOMIC_ACQUIRE, "agent");
            xb_add(&bar[XB_XGEN(b.x)], 1u);
            asm volatile("s_waitcnt vmcnt(0)" ::: "memory");
        } else {
            XB_SPIN(xb_ld(&bar[XB_XGEN(b.x)]) == gen, bar);
            __builtin_amdgcn_fence(__ATOMIC_ACQUIRE, "agent");
            asm volatile("s_waitcnt vmcnt(0)" ::: "memory");
        }
    }
    __syncthreads();
}
#define IDS const int tid = fresh_tid(wave_s); const int lane = tid & 63, wave = wave_s; const int gw = bid * 8 + wave; const size_t gtid = (size_t)bid * 512 + tid; (void)lane; (void)gw; (void)gtid;
#define GSYNC() xcd_barrier(xbar, fresh_tid(wave_s) == 0)
template <int l>
__device__ __forceinline__ void layer_body(const Params& p, unsigned char* lds, int* s_item_p, int wave_s, const XcdBarrier& xbar) {
    const int G = gridDim.x, bid = blockIdx.x;
    const int NGW = G * 8; const size_t NGT = (size_t)G * 512;
#define PHASE_WS unsigned char* ws = p.ws; asm volatile("" : "+s"(ws)); float* outp = p.out; asm volatile("" : "+s"(outp)); unsigned* ctl = (unsigned*)(ws + WS_CTL); float* ssq = (float*)(ws + WS_SSP); float* X = (float*)(ws + WS_X); bf16_t* XN = (bf16_t*)(ws + WS_XN); unsigned char* wl = ws + WS_W + (size_t)l * W_LSTRIDE; (void)ctl; (void)ssq; (void)X; (void)XN; (void)wl; (void)outp;
    LAS unsigned char* lds3 = (LAS unsigned char*)lds;
    (void)NGW; (void)NGT;
#define s_item (*s_item_p)
        {
            PHASE_WS
            pg8::Gemm g{XN, (const bf16_t*)wl, M, NIN, 1024}; pg8::StaticOrder S; S.init(M, NIN, G, bid);
            EpiIn E; E.ss = ssq + (size_t)(2 * l) * M * 16; E.QA = (bf16_t*)(ws + WS_QA); E.KP = (bf16_t*)(ws + WS_KP); E.KS = (bf16_t*)(ws + WS_KS); E.VTP = (bf16_t*)(ws + WS_VTP); E.VTS = (bf16_t*)(ws + WS_VTS);
            E.QKVB = (bf16_t*)(ws + WS_QKVB); E.Z = (bf16_t*)(ws + WS_Z); E.GA = (bf16_t*)(ws + WS_GA); E.GB = (bf16_t*)(ws + WS_GB); E.BA = (float*)(ws + WS_BA);
            E.okp = outp + O_KP + (size_t)l * 16777216; E.ovp = outp + O_VP + (size_t)l * 16777216; E.oks = outp + O_KS + (size_t)l * 524288; E.ovs = outp + O_VS + (size_t)l * 524288;
            E.ogcp = outp + O_GCP + (size_t)l * 9216; E.ogcs = outp + O_GCS + (size_t)l * 73728;

#ifndef NO_G1
            pg8::gemm_phase<EpiIn, true, true>(lds3, g, S, E, wave_s);
#endif
        }
        GSYNC();
        {
            PHASE_WS
            IDS
#ifndef NO_PREP
            {
                const bf16_t* KPp = (const bf16_t*)(ws + WS_KP); float mxr = 0.f;
                for (int row = gw; row < TP; row += NGW) { const u32x4 a = *(const u32x4*)(KPp + (size_t)row * 1024 + lane * 16), b = *(const u32x4*)(KPp + (size_t)row * 1024 + lane * 16 + 8);
                    float ss = (bflo(a.x) * bflo(a.x) + bfhi(a.x) * bfhi(a.x)) + (bflo(a.y) * bflo(a.y) + bfhi(a.y) * bfhi(a.y)) + (bflo(a.z) * bflo(a.z) + bfhi(a.z) * bfhi(a.z)) + (bflo(a.w) * bflo(a.w) + bfhi(a.w) * bfhi(a.w))
                             + (bflo(b.x) * bflo(b.x) + bfhi(b.x) * bfhi(b.x)) + (bflo(b.y) * bflo(b.y) + bfhi(b.y) * bfhi(b.y)) + (bflo(b.z) * bflo(b.z) + bfhi(b.z) * bfhi(b.z)) + (bflo(b.w) * bflo(b.w) + bfhi(b.w) * bfhi(b.w));
                    ss += __shfl_xor(ss, 1); ss += __shfl_xor(ss, 2); mxr = fmaxf(mxr, ss); }
                if ((lane & 3) == 0) atomicMax(ctl + 16 + l * 16 + (lane >> 2), __float_as_uint(mxr));
            }
#endif
        }
        GSYNC();
        {
            PHASE_WS
            float lam, lam0;
            { float s1 = 0.f, s2 = 0.f;
              const float* q1 = INP(9) + l * 64; const float* k1 = INP(10) + l * 64; const float* q2 = INP(11) + l * 64; const float* k2 = INP(12) + l * 64;
              for (int i = 0; i < 64; ++i) { s1 += q1[i] * k1[i]; s2 += q2[i] * k2[i]; }
              lam0 = uni(0.8f - 0.6f * __expf(-0.3f * (float)l)); lam = uni(__expf(s1) - __expf(s2) + lam0); }
            if (fresh_tid(wave_s) == 0) { ((float*)s_item_p)[1] = lam; ((float*)s_item_p)[2] = 1.f - lam0; }
            const float* subg = INP(13) + l * 128;
            for (;;) {
                __syncthreads();
                if (fresh_tid(wave_s) == 0) s_item = (int)atomicAdd(ctl + l, 1u);
                __syncthreads();
                asm volatile("" : "+s"(ws), "+s"(outp));
                int it = __builtin_amdgcn_readfirstlane(s_item);
                if (it >= 3272) break;
                int kind, idx;
                if (it < 8) { kind = 0; idx = it; }
                else if (it < 72) { kind = 3; idx = it - 8; }
                else if (it < 328) { kind = 1; idx = it - 72; }
                else if (it < 624) { const int o = it - 328; if (o < 64) { kind = 3; idx = 64 + o; } else { kind = 1; idx = 256 + (o - 64); } }
                else if (it < 1136) { kind = 5; idx = it - 624; }
                else if (it < 1200) { kind = 2; idx = it - 1136; }
                else if (it < 2976) { const int r = it - 1200, blk = 1 + r / 296, o = r % 296; if (o < 64) { kind = 3; idx = 64 + blk * 64 + o; } else { kind = 1; idx = 256 + blk * 232 + (o - 64); } }
                else if (it < 3208) { kind = 1; idx = 1880 + (it - 2976); }
                else { kind = 4; idx = it - 3208; }
                unsigned* rdyb = ctl + 8192 + l * 2112;
                if (kind == 0) {
                    gdn_scan_unit(lds, ws, INP(17) + l * 128, 0, 256, idx, nullptr, outp + O_GP + (size_t)l * 131072 + (size_t)idx * 16384, wave_s, rdyb + idx * 264);
                } else if (kind == 1) {
                    gdn_prep_unit(lds, p, l, idx >> 3, idx & 7, wave_s);
                } else if (kind == 5) {
                    cache_conv_unit(lds, p, ws, l, idx & 7, idx >> 3, wave_s);
                } else if (kind == 2) {
                    const int b = idx >> 3, h = idx & 7; const float sl2 = uni(exp2f(-(float)(h + 1)) * LOG2E);
                    {
                        if (fresh_tid(wave_s) == 0) { unsigned sp = 0; while (__hip_atomic_load(ctl + 48 + l * 8 + b, __ATOMIC_RELAXED, __HIP_MEMORY_SCOPE_AGENT) < 64u) { __builtin_amdgcn_s_sleep(8); if (++sp > (1u << 24)) break; } }
                        __syncthreads(); __builtin_amdgcn_fence(__ATOMIC_ACQUIRE, "agent"); }
                    attn_unit(lds, (const bf16_t*)(ws + WS_QA) + (size_t)(TP + 64 * b) * 1024 + h * 128, (const bf16_t*)(ws + WS_KS) + (size_t)b * KVS * 1024 + h * 128,
                              (const bf16_t*)(ws + WS_VTS) + (size_t)((b * 8 + h) * 128) * KVS, KVS, (bf16_t*)(ws + WS_OA) + (size_t)(TP + 64 * b) * 1024 + h * 128,
                              2, PAST, 65, sl2, (const float*)s_item_p + 1, subg, wave_s, nullptr);
                } else if (kind == 3) {
                    const int qb = 63 - (idx >> 3), h = idx & 7; const float sl2 = uni(exp2f(-(float)(h + 1)) * LOG2E);
                    attn_unit(lds, (const bf16_t*)(ws + WS_QA) + (size_t)(256 * qb) * 1024 + h * 128, (const bf16_t*)(ws + WS_KP) + h * 128,
                              (const bf16_t*)(ws + WS_VTP) + (size_t)(h * 128) * TP, TP, (bf16_t*)(ws + WS_OA) + (size_t)(256 * qb) * 1024 + h * 128,
                              8, 256 * qb, 4 * qb + 4, sl2, (const float*)s_item_p + 1, subg, wave_s, ctl + 16 + l * 16 + h * 2);
                } else {
                    const int b = idx >> 3, h = idx & 7;
                    gdn_scan_unit(lds, ws, INP(17) + l * 128, 256 + b, 1, h, INP(4) + ((size_t)(l * 8 + b) * 8 + h) * 16384, outp + O_GS + (size_t)l * 1048576 + ((size_t)b * 8 + h) * 16384, wave_s, rdyb + h * 264 + 256 + b);
                }
            }
        }
        GSYNC();
        {
            PHASE_WS
            pg8::StaticOrder S; S.init(M, 1024, G, bid);
            { pg8::Gemm g{(const bf16_t*)(ws + WS_OA), (const bf16_t*)(wl + 19 * MiB), M, 1024, 1024}; EpiGateA E{(const bf16_t*)(ws + WS_GA), (float*)(ws + WS_MG)};

#if !defined(NO_G2) && !defined(NO_G2A)
              pg8::gemm_phase<EpiGateA, true, true>(lds3, g, S, E, wave_s);
#endif
 }
            __syncthreads();
            { pg8::Gemm g{(const bf16_t*)(ws + WS_OB), (const bf16_t*)(wl + 21 * MiB), M, 1024, 1024}; EpiGateB E{(const bf16_t*)(ws + WS_GB), (const float*)(ws + WS_MG), (bf16_t*)(ws + WS_MERGED)};

#if !defined(NO_G2) && !defined(NO_G2B)
              pg8::gemm_phase<EpiGateB, true, true>(lds3, g, S, E, wave_s);
#endif
 }
        }
        GSYNC();
        {
            PHASE_WS
            pg8::Gemm g{(const bf16_t*)(ws + WS_MERGED), (const bf16_t*)(wl + 23 * MiB), M, 1024, 1024}; pg8::StaticOrder S; S.init(M, 1024, G, bid);
            EpiRes E{X, INP(21) + l * 1024, XN, ssq + (size_t)(2 * l + 1) * M * 16};
#if !defined(NO_G2) && !defined(NO_G2R)
            pg8::gemm_phase<EpiRes, true, true>(lds3, g, S, E, wave_s);
#endif
        }
        GSYNC();
        {
            PHASE_WS
            pg8::Gemm g{XN, (const bf16_t*)(wl + 25 * MiB), M, FF2, 1024}; pg8::StaticOrder S; S.init(M, FF2, G, bid);
            EpiUp E{ssq + (size_t)(2 * l + 1) * M * 16, (bf16_t*)(ws + WS_U), outp + O_FCP + (size_t)l * 11264, outp + O_FCS + (size_t)l * 90112};
#if !defined(NO_G2) && !defined(NO_G2U)
            pg8::gemm_phase<EpiUp, true, true>(lds3, g, S, E, wave_s);
#endif
        }
        GSYNC();
        {
            PHASE_WS
            IDS
            const bf16_t* U = (const bf16_t*)(ws + WS_U); bf16_t* ACT = (bf16_t*)(ws + WS_ACT);
            const float* cw = INP(23) + (size_t)l * 3 * FF2; const float* cb = INP(24) + (size_t)l * FF2;
            for (size_t it_ = gtid; it_ < (size_t)(M / 16) * 352 * PROBE_MISC; it_ += NGT) { const size_t it = it_ % ((size_t)(M / 16) * 352);
                const int seg = (int)(it / 352), cg8 = (int)(it % 352), f0 = cg8 * 8, r0 = seg * 16;
                float wg[3][8], wv[3][8], bg[8], bv[8];
#pragma unroll
                for (int j = 0; j < 8; ++j) { bg[j] = cb[f0 + j]; bv[j] = cb[FF + f0 + j];
#pragma unroll
                    for (int k = 0; k < 3; ++k) { wg[k][j] = cw[k * FF2 + f0 + j]; wv[k][j] = cw[k * FF2 + FF + f0 + j]; } }
                float g2[8], g1[8], v2[8], v1[8];
                const bool samp = r0 >= TP; const int spos = samp ? ((r0 - TP) & 63) : r0;
                if (spos == 0) {
                    if (samp) { const float* sc = INP(6) + ((size_t)(l * 8 + ((r0 - TP) >> 6)) * 2) * FF2;
#pragma unroll
                        for (int j = 0; j < 8; ++j) { g2[j] = sc[f0 + j]; v2[j] = sc[FF + f0 + j]; g1[j] = sc[FF2 + f0 + j]; v1[j] = sc[FF2 + FF + f0 + j]; } }
                    else {
#pragma unroll
                        for (int j = 0; j < 8; ++j) { g2[j] = 0.f; v2[j] = 0.f; g1[j] = 0.f; v1[j] = 0.f; } }
                } else {
                    const u32x4 a2 = *(const u32x4*)(U + (size_t)(r0 - 2) * FF2 + f0), b2 = *(const u32x4*)(U + (size_t)(r0 - 2) * FF2 + FF + f0);
                    const u32x4 a1 = *(const u32x4*)(U + (size_t)(r0 - 1) * FF2 + f0), b1 = *(const u32x4*)(U + (size_t)(r0 - 1) * FF2 + FF + f0);
                    g2[0] = bflo(a2.x); g2[1] = bfhi(a2.x); g2[2] = bflo(a2.y); g2[3] = bfhi(a2.y); g2[4] = bflo(a2.z); g2[5] = bfhi(a2.z); g2[6] = bflo(a2.w); g2[7] = bfhi(a2.w);
                    v2[0] = bflo(b2.x); v2[1] = bfhi(b2.x); v2[2] = bflo(b2.y); v2[3] = bfhi(b2.y); v2[4] = bflo(b2.z); v2[5] = bfhi(b2.z); v2[6] = bflo(b2.w); v2[7] = bfhi(b2.w);
                    g1[0] = bflo(a1.x); g1[1] = bfhi(a1.x); g1[2] = bflo(a1.y); g1[3] = bfhi(a1.y); g1[4] = bflo(a1.z); g1[5] = bfhi(a1.z); g1[6] = bflo(a1.w); g1[7] = bfhi(a1.w);
                    v1[0] = bflo(b1.x); v1[1] = bfhi(b1.x); v1[2] = bflo(b1.y); v1[3] = bfhi(b1.y); v1[4] = bflo(b1.z); v1[5] = bfhi(b1.z); v1[6] = bflo(b1.w); v1[7] = bfhi(b1.w);
                }
#pragma unroll 4
                for (int rr = 0; rr < 16; ++rr) {
                    const size_t row = (size_t)(r0 + rr);
                    const u32x4 a0 = *(const u32x4*)(U + row * FF2 + f0), b0 = *(const u32x4*)(U + row * FF2 + FF + f0);
                    float g0[8], v0[8], o[8];
                    g0[0] = bflo(a0.x); g0[1] = bfhi(a0.x); g0[2] = bflo(a0.y); g0[3] = bfhi(a0.y); g0[4] = bflo(a0.z); g0[5] = bfhi(a0.z); g0[6] = bflo(a0.w); g0[7] = bfhi(a0.w);
                    v0[0] = bflo(b0.x); v0[1] = bfhi(b0.x); v0[2] = bflo(b0.y); v0[3] = bfhi(b0.y); v0[4] = bflo(b0.z); v0[5] = bfhi(b0.z); v0[6] = bflo(b0.w); v0[7] = bfhi(b0.w);
#pragma unroll
                    for (int j = 0; j < 8; ++j) { const float gc = wg[0][j] * g2[j] + wg[1][j] * g1[j] + wg[2][j] * g0[j] + bg[j]; const float vc = wv[0][j] * v2[j] + wv[1][j] * v1[j] + wv[2][j] * v0[j] + bv[j];
                        o[j] = siluf_(gc) * vc; g2[j] = g1[j]; g1[j] = g0[j]; v2[j] = v1[j]; v1[j] = v0[j]; }
                    u32x4 w; w.x = pk2(o[0], o[1]); w.y = pk2(o[2], o[3]); w.z = pk2(o[4], o[5]); w.w = pk2(o[6], o[7]);
                    *(u32x4*)(ACT + row * FF + f0) = w;
                }
            }
        }
        GSYNC();
        {
            PHASE_WS
            pg8::Gemm g{(const bf16_t*)(ws + WS_ACT), (const bf16_t*)(wl + 36 * MiB), M, 1024, FF}; pg8::StaticOrder S; S.init(M, 1024, G, bid);
            EpiRes E{X, l == 0 ? INP(7) + 1024 : INP(26), XN, ssq + (size_t)(2 * l + 2) * M * 16};
#if !defined(NO_G2) && !defined(NO_G2R)
            pg8::gemm_phase<EpiRes, true, true>(lds3, g, S, E, wave_s);
#endif
        }
        GSYNC();
#undef s_item
}

__global__ void __launch_bounds__(512, 2) hybrid_fwd(Params p) {
    extern __shared__ __attribute__((aligned(16))) unsigned char lds[];
    cg::grid_group grid = cg::this_grid();
    const int wave_s = __builtin_amdgcn_readfirstlane((int)(threadIdx.x >> 6));
    const int G = gridDim.x, bid = blockIdx.x;
    const int NGW = G * 8; const size_t NGT = (size_t)G * 512;
    unsigned char* ws = p.ws;
    unsigned* ctl = (unsigned*)(ws + WS_CTL);
    float* ssq = (float*)(ws + WS_SSP);
    float* X = (float*)(ws + WS_X); bf16_t* XN = (bf16_t*)(ws + WS_XN);
    LAS unsigned char* lds3 = (LAS unsigned char*)lds;
    __shared__ int s_item[8];

    if (fresh_tid(wave_s) == 0) { s_item[4] = 0; s_item[5] = 0; }
    __syncthreads();
    const XcdBarrier xbar = xcd_barrier_post(ctl + 4096, (volatile LAS unsigned*)(LAS int*)s_item + 4, fresh_tid(wave_s) == 0);
    {
    IDS
    {
        float* scr = (float*)(lds + wave * 8448);
        constexpr int I_A = 16 * 192, I_B = 16 * 96, I_P = 16 * 32, I_UP = 16 * 176, I_DN = 44 * 32;
        constexpr int PER_L = I_A + I_B + 3 * I_P + I_UP + I_DN;
        for (int it_ = gw; it_ < 2 * PER_L * PROBE_MISC; it_ += NGW) { const int it = it_ % (2 * PER_L);
            const int l = it / PER_L; int r = it % PER_L;
            unsigned char* wl = ws + WS_W + (size_t)l * W_LSTRIDE;
            const float* src; size_t sp; bf16_t* dst; size_t dp; int kb, nb;
            if (r < I_A) { kb = r / 192; nb = r % 192; src = INP(8) + (size_t)l * 1024 * 9232 + (size_t)(64 * kb) * 9232 + 32 * nb; sp = 9232; dst = (bf16_t*)wl + (size_t)(32 * nb) * 1024 + 64 * kb; dp = 1024; }
            else if ((r -= I_A) < I_B) { kb = r / 96; nb = r % 96; src = INP(8) + (size_t)l * 1024 * 9232 + (size_t)(64 * kb) * 9232 + 6160 + 32 * nb; sp = 9232; dst = (bf16_t*)wl + (size_t)(6144 + 32 * nb) * 1024 + 64 * kb; dp = 1024; }
            else if ((r -= I_B) < I_P) { kb = r / 32; nb = r % 32; src = INP(18) + (size_t)l * 1024 * 1024 + (size_t)(64 * kb) * 1024 + 32 * nb; sp = 1024; dst = (bf16_t*)(wl + 19 * MiB) + (size_t)(32 * nb) * 1024 + 64 * kb; dp = 1024; }
            else if ((r -= I_P) < I_P) { kb = r / 32; nb = r % 32; src = INP(19) + (size_t)l * 1024 * 1024 + (size_t)(64 * kb) * 1024 + 32 * nb; sp = 1024; dst = (bf16_t*)(wl + 21 * MiB) + (size_t)(32 * nb) * 1024 + 64 * kb; dp = 1024; }
            else if ((r -= I_P) < I_P) { kb = r / 32; nb = r % 32; src = INP(20) + (size_t)l * 1024 * 1024 + (size_t)(64 * kb) * 1024 + 32 * nb; sp = 1024; dst = (bf16_t*)(wl + 23 * MiB) + (size_t)(32 * nb) * 1024 + 64 * kb; dp = 1024; }
            else if ((r -= I_P) < I_UP) { kb = r / 176; nb = r % 176; src = INP(22) + (size_t)l * 1024 * FF2 + (size_t)(64 * kb) * FF2 + 32 * nb; sp = FF2; dst = (bf16_t*)(wl + 25 * MiB) + (size_t)(32 * nb) * 1024 + 64 * kb; dp = 1024; }
            else { r -= I_UP; kb = r / 32; nb = r % 32; src = INP(25) + (size_t)l * FF * 1024 + (size_t)(64 * kb) * 1024 + 32 * nb; sp = 1024; dst = (bf16_t*)(wl + 36 * MiB) + (size_t)(32 * nb) * FF + 64 * kb; dp = FF; }
            transpose_item(src, sp, dst, dp, scr, lane);
        }
        const float* win = INP(8);
        for (size_t i = gtid; i < 2 * 16 * 1024; i += NGT) { const int l = (int)(i >> 14), j = (int)((i >> 10) & 15), k = (int)(i & 1023);
            ((bf16_t*)(ws + WS_W + (size_t)l * W_LSTRIDE))[(size_t)(9216 + j) * 1024 + k] = (bf16_t)f2bf(win[(size_t)l * 1024 * 9232 + (size_t)k * 9232 + 6144 + j]); }
        const float* g0 = INP(7); const float* xin0 = INP(0); const float* xin1 = INP(1);
        for (int mrow_ = gw; mrow_ < M * PROBE_MISC; mrow_ += NGW) { const int mrow = mrow_ % M;
            const float* xr = mrow < TP ? xin0 + (size_t)mrow * 1024 : xin1 + (size_t)(mrow - TP) * 1024;
            float s = 0.f;
#pragma unroll
            for (int j = 0; j < 4; ++j) { const int c = 4 * lane + 256 * j; const f32x4 v = *(const f32x4*)(xr + c); const f32x4 gg = *(const f32x4*)(g0 + c);
                *(f32x4*)(X + (size_t)mrow * 1024 + c) = v; s += (v[0] * v[0] + v[1] * v[1]) + (v[2] * v[2] + v[3] * v[3]);
                u32x2 w; w.x = pk2(v[0] * gg[0], v[1] * gg[1]); w.y = pk2(v[2] * gg[2], v[3] * gg[3]); *(u32x2*)(XN + (size_t)mrow * 1024 + c) = w; }
            s = wave_sum(s); if (lane < 16) ssq[(size_t)mrow * 16 + lane] = lane == 0 ? s : 0.f;
        }
    }
    }
    asm volatile("s_waitcnt vmcnt(0) lgkmcnt(0)" ::: "memory"); grid.sync();

    layer_body<0>(p, lds, s_item, wave_s, xbar);
    layer_body<1>(p, lds, s_item, wave_s, xbar);
    {
        IDS
        const float* gf = INP(26); const float* ss4 = ssq + (size_t)4 * M * 16;
        for (size_t i_ = gtid; i_ < (size_t)M * 256 * PROBE_MISC; i_ += NGT) { const size_t i = i_ % ((size_t)M * 256); const size_t row = i >> 8; const int c = (int)(i & 255) * 4;
            const float rs = rsqrtf(ss16(ss4 + row * 16) * (1.f / 1024.f) + EPS); const f32x4 v = *(const f32x4*)(X + row * 1024 + c); const f32x4 gg = *(const f32x4*)(gf + c);
            *(f32x4*)(p.out + O_YP + row * 1024 + c) = v * rs * gg; }
    }
}

extern "C" void kernel_launch(void* const* d_in, const int* in_sizes, int n_in, void* d_out, int out_size, void* d_ws, size_t ws_size, hipStream_t stream) {
    static int grid_blocks = 0;
    if (!grid_blocks) {
        int dev = 0, cus = 0, per_cu = 0;
        hipGetDevice(&dev);
        hipDeviceGetAttribute(&cus, hipDeviceAttributeMultiprocessorCount, dev);
        hipFuncSetAttribute((const void*)hybrid_fwd, hipFuncAttributeMaxDynamicSharedMemorySize, LDS_BYTES);
        hipOccupancyMaxActiveBlocksPerMultiprocessor(&per_cu, (const void*)hybrid_fwd, 512, LDS_BYTES);
        if (per_cu < 1) per_cu = 1;
        if (per_cu > 1) per_cu = 1;
        grid_blocks = cus * per_cu;
        (void)hipGetLastError();
    }
    Params p{};
    for (int i = 0; i < 27; ++i) p.in[i] = (const float*)d_in[i];
    p.out = (float*)d_out; p.ws = (unsigned char*)d_ws;
    (void)hipMemsetAsync(d_ws, 0, 65536, stream);
    void* args[] = {&p};
    hipError_t e = hipLaunchCooperativeKernel((const void*)hybrid_fwd, dim3(grid_blocks), dim3(512), args, LDS_BYTES, stream);
    if (e != hipSuccess) fprintf(stderr, "cooperative launch failed: %s (grid %d)\n", hipGetErrorString(e), grid_blocks);
}
```

```cpp
#include <hip/hip_runtime.h>
#include <hip/hip_cooperative_groups.h>
#include <cstdio>
#include <cstdint>
namespace cg = cooperative_groups;

#define LAS __attribute__((address_space(3)))
#define GAS __attribute__((address_space(1)))
typedef unsigned short bf16_t;
typedef short bf16x8 __attribute__((ext_vector_type(8)));
typedef short s16x4 __attribute__((ext_vector_type(4)));
typedef float f32x4 __attribute__((ext_vector_type(4)));
typedef float f32x16 __attribute__((ext_vector_type(16)));
typedef unsigned u32x4 __attribute__((ext_vector_type(4)));
typedef unsigned u32x2 __attribute__((ext_vector_type(2)));

#ifndef PROBE_SCAN
#define PROBE_SCAN 1
#endif
#ifndef PROBE_PREP
#define PROBE_PREP 1
#endif
#ifndef PROBE_MISC
#define PROBE_MISC 1
#endif
#ifndef PROBE_P2B
#define PROBE_P2B 1
#endif
constexpr int D = 1024, TP = 16384, NSROWS = 512, M = TP + NSROWS;
constexpr int PAST = 4096, KVS = PAST + 64;
constexpr int NIN = 9472;
constexpr int FF = 2816, FF2 = 5632;
constexpr float EPS = 1e-6f;
constexpr float QSCALE = 0.125f * 1.4426950408889634f;
constexpr float LOG2E = 1.4426950408889634f;

constexpr size_t O_YP = 0, O_KP = 17301504, O_VP = 50855936, O_GP = 84410368, O_GCP = 84672512, O_FCP = 84690944,
                 O_KS = 84713472, O_VS = 85762048, O_GS = 86810624, O_GCS = 88907776, O_FCS = 89055232;

constexpr size_t MiB = 1u << 20;
constexpr size_t WS_CTL = 0;
constexpr size_t CTL_SS = 65536;
constexpr size_t WS_W = 1 * MiB, W_LSTRIDE = 42 * MiB;
constexpr size_t WS_X = 86 * MiB, WS_XN = 152 * MiB;
constexpr size_t WS_KS = 185 * MiB, WS_VTS = 250 * MiB;
constexpr size_t WS_QA = 315 * MiB, WS_KP = 348 * MiB, WS_VTP = 380 * MiB;
constexpr size_t WS_MG = 315 * MiB, WS_MERGED = 381 * MiB;
constexpr size_t WS_QKVB = 414 * MiB, WS_Z = 513 * MiB, WS_GA = 546 * MiB, WS_GB = 579 * MiB, WS_BA = 612 * MiB;
constexpr size_t WS_U = 414 * MiB;
constexpr size_t WS_GDNP = 614 * MiB, WS_ACT = 614 * MiB;
constexpr size_t WS_OA = 798 * MiB, WS_OB = 831 * MiB;
constexpr size_t WS_SSP = 864 * MiB;
constexpr size_t BLOB = 91136;
constexpr int BLOB_A = 57344, BLOB_U = 57344, BLOB_EG = 90112;
constexpr int LDS_BYTES = 155648;

__device__ __forceinline__ unsigned f2bf(float f) { unsigned u = __builtin_bit_cast(unsigned, f); return (u + 0x7fffu + ((u >> 16) & 1u)) >> 16; }
typedef float f32x2_t __attribute__((ext_vector_type(2))); typedef __bf16 bf16x2_t __attribute__((ext_vector_type(2)));
__device__ __forceinline__ unsigned pk2(float lo, float hi) { f32x2_t v = {lo, hi}; bf16x2_t b = __builtin_convertvector(v, bf16x2_t); return __builtin_bit_cast(unsigned, b); }
__device__ __forceinline__ float bf2f(bf16_t b) { return __uint_as_float((unsigned)b << 16); }
__device__ __forceinline__ float bflo(unsigned w) { return __uint_as_float(w << 16); }
__device__ __forceinline__ float bfhi(unsigned w) { return __uint_as_float(w & 0xffff0000u); }
__device__ __forceinline__ float sigmoidf_(float x) { return __builtin_amdgcn_rcpf(1.f + __expf(-x)); }
__device__ __forceinline__ float siluf_(float x) { return x * __builtin_amdgcn_rcpf(1.f + __expf(-x)); }
__device__ __forceinline__ void st_bf8(bf16_t* p, f32x4 a, f32x4 b) { u32x4 w; w.x = pk2(a[0], a[1]); w.y = pk2(a[2], a[3]); w.z = pk2(b[0], b[1]); w.w = pk2(b[2], b[3]); *(u32x4*)p = w; }
__device__ __forceinline__ void st_f8(float* p, f32x4 a, f32x4 b) { *(f32x4*)p = a; *(f32x4*)(p + 4) = b; }
__device__ __forceinline__ bf16x8 pack8(float a0, float a1, float a2, float a3, float a4, float a5, float a6, float a7) {
    u32x4 w; w.x = pk2(a0, a1); w.y = pk2(a2, a3); w.z = pk2(a4, a5); w.w = pk2(a6, a7); return __builtin_bit_cast(bf16x8, w); }
__device__ __forceinline__ float wave_sum(float v) {
#pragma unroll
    for (int o = 1; o < 64; o <<= 1) v += __shfl_xor(v, o);
    return v;
}
__device__ __forceinline__ float ss16(const float* p) { const f32x4 a = *(const f32x4*)p, b = *(const f32x4*)(p + 4), c = *(const f32x4*)(p + 8), d = *(const f32x4*)(p + 12);
    return (((a[0] + a[1]) + (a[2] + a[3])) + ((b[0] + b[1]) + (b[2] + b[3]))) + (((c[0] + c[1]) + (c[2] + c[3])) + ((d[0] + d[1]) + (d[2] + d[3]))); }
__device__ __forceinline__ int fresh_tid(int wave_s) { unsigned m = ~0u; asm volatile("" : "+s"(m)); return wave_s * 64 + (int)__builtin_amdgcn_mbcnt_hi(m, __builtin_amdgcn_mbcnt_lo(m, 0u)); }
__device__ __forceinline__ int crow(int r, int hi) { return (r & 3) + 8 * (r >> 2) + 4 * hi; }

namespace pg8 {
constexpr int BM = 256, BK = 64, HALF = 128, HTB = HALF * BK * 2, STAGE_BYTES = 8 * HTB, NXCD = 8, WGM = 8;
__host__ __device__ __forceinline__ int lds_byte(int r, int c) { const int st = (r >> 4) * 2 + (c >> 5), rr = r & 15, cc = c & 31, ob = rr * 64 + cc * 2; return st * 1024 + (ob ^ (((ob >> 9) & 1) << 5)); }
__host__ __device__ __forceinline__ void stage_rc(int b, int& R, int& C) { const int st = b / 1024, sb = b % 1024, swz = sb ^ (((sb >> 9) & 1) << 5); R = (st >> 1) * 16 + swz / 64; C = (st & 1) * 32 + (swz % 64) / 2; }
__host__ __device__ __forceinline__ int perm32(int rho) { const int n = rho >> 4, i = rho & 15; return 8 * (i >> 2) + 4 * n + (i & 3); }
struct Unit { int pm, pn; };
struct Gemm { const bf16_t* A; const bf16_t* Bt; int M, N, K; };
struct StaticOrder {
    int nM, nN, nwg, G, c;
    __host__ __device__ void init(int M_, int N_, int G_, int c_) { nM = M_ / BM; nN = N_ / BM; nwg = nM * nN; G = G_; c = c_; }
    __host__ __device__ bool next(int i, Unit& u) const {
        const long L = (long)i * G + c; if (L >= nwg) return false;
        int wgid = (int)L; { const int q = nwg / NXCD, r = nwg % NXCD, xcd = wgid % NXCD, off = wgid / NXCD; wgid = (xcd < r ? xcd * (q + 1) : r * (q + 1) + (xcd - r) * q) + off; }
        const int nig = WGM * nN, gid = wgid / nig, fm = gid * WGM, gsz = (nM - fm) < WGM ? (nM - fm) : WGM;
        u.pm = fm + ((wgid % nig) % gsz); u.pn = (wgid % nig) / gsz; return true;
    }
};
template <class Epi, bool ALIGN_EPI, bool SP2>
__device__ __forceinline__ void gemm_phase(LAS unsigned char* lds, const Gemm g, const StaticOrder& S, const Epi& E, int wave_s) {
    const int tid = fresh_tid(wave_s);
    const int wid = wave_s, lane = tid & 63, wr = wid >> 2, wc = wid & 3, fr = lane & 15, fq = lane >> 4;
    const int K = g.K, nt = K / BK;
    unsigned voffA[2], voffB[2];
#pragma unroll
    for (int i = 0; i < 2; ++i) { int R, C; stage_rc(tid * 16 + i * 8192, R, C); const int Rb = Epi::PERM ? ((R & ~31) + perm32(R & 31)) : R;
        voffA[i] = (unsigned)(R * K + C) * 2u; voffB[i] = (unsigned)(Rb * K + C) * 2u; }
    const size_t kstep = (size_t)(BK * 2);
    const size_t hstep = (size_t)HALF * K * 2;
    const size_t tstep = 2 * hstep;
    const unsigned ldsw = (unsigned)wid * 1024u;
    const int aoff = lds_byte(wr * 64 + fr, fq * 8), boff = lds_byte(wc * 32 + fr, fq * 8);
#define PG8_SA(b, h) (((b) * 2 + (h)) * HTB)
#define PG8_SB(b, h) ((4 + (b) * 2 + (h)) * HTB)
#define PG8_STAGE(bufoff, gbase, voff) do { _Pragma("unroll") for (int _i = 0; _i < 2; ++_i) \
        __builtin_amdgcn_global_load_lds((const unsigned*)((const char*)(gbase) + (voff)[_i]), (LAS unsigned*)(lds + (bufoff) + ldsw + _i * 8192), 16, 0, 0); } while (0)
#define PG8_LDA(dst, b, h) do { _Pragma("unroll") for (int m = 0; m < 4; ++m) _Pragma("unroll") for (int k = 0; k < 2; ++k) dst[m][k] = *(const LAS bf16x8*)(lds + PG8_SA(b, h) + aoff + m * 2048 + k * 1024); } while (0)
#define PG8_LDB(dst, b, h) do { _Pragma("unroll") for (int n = 0; n < 2; ++n) _Pragma("unroll") for (int k = 0; k < 2; ++k) dst[n][k] = *(const LAS bf16x8*)(lds + PG8_SB(b, h) + boff + n * 2048 + k * 1024); } while (0)
#define PG8_MMA(ai, bj, At, Bt) do { __builtin_amdgcn_s_setprio(1); _Pragma("unroll") for (int m = 0; m < 4; ++m) _Pragma("unroll") for (int n = 0; n < 2; ++n) _Pragma("unroll") for (int k = 0; k < 2; ++k) \
        acc[ai][bj][m][n] = __builtin_amdgcn_mfma_f32_16x16x32_bf16(Bt[n][k], At[m][k], acc[ai][bj][m][n], 0, 0, 0); __builtin_amdgcn_s_setprio(0); } while (0)
#define PG8_WAIT_V(n) asm volatile("s_waitcnt vmcnt(" #n ")" ::: "memory")
#define PG8_WAIT_L(n) asm volatile("s_waitcnt lgkmcnt(" #n ")" ::: "memory")
#define PG8_BAR __builtin_amdgcn_s_barrier()
#define PG8_SCHED __builtin_amdgcn_sched_barrier(0)
    Unit cur, nxt; int ui = 0;
    if (!S.next(0, cur)) return;
    f32x4 acc[2][2][4][2];
#pragma unroll
    for (int a = 0; a < 2; ++a)
#pragma unroll
        for (int b = 0; b < 2; ++b)
#pragma unroll
            for (int m = 0; m < 4; ++m)
#pragma unroll
                for (int n = 0; n < 2; ++n) acc[a][b][m][n] = (f32x4){0.f, 0.f, 0.f, 0.f};
    bf16x8 At[4][2], B0[2][2], B1[2][2];
    const char* cA = (const char*)g.A + (size_t)cur.pm * tstep; const char* cB = (const char*)g.Bt + (size_t)cur.pn * tstep;
    if constexpr (SP2) {
        PG8_STAGE(PG8_SB(0, 0), cB, voffB); PG8_STAGE(PG8_SB(0, 1), cB + hstep, voffB); PG8_STAGE(PG8_SA(0, 0), cA, voffA); PG8_STAGE(PG8_SA(0, 1), cA + hstep, voffA);
        if (wr == 1) PG8_BAR;
        PG8_WAIT_V(2); PG8_BAR;
        PG8_STAGE(PG8_SB(1, 0), cB + kstep, voffB); PG8_STAGE(PG8_SA(1, 0), cA + kstep, voffA); PG8_STAGE(PG8_SB(1, 1), cB + hstep + kstep, voffB);
        PG8_WAIT_V(6); PG8_BAR;
    } else {
        PG8_STAGE(PG8_SB(0, 0), cB, voffB); PG8_STAGE(PG8_SA(0, 0), cA, voffA); PG8_STAGE(PG8_SB(0, 1), cB + hstep, voffB); PG8_STAGE(PG8_SA(0, 1), cA + hstep, voffA);
        if (wr == 1) PG8_BAR;
        PG8_WAIT_V(4); PG8_BAR;
        PG8_STAGE(PG8_SB(1, 0), cB + kstep, voffB); PG8_STAGE(PG8_SA(1, 0), cA + kstep, voffA); PG8_STAGE(PG8_SB(1, 1), cB + hstep + kstep, voffB);
        PG8_WAIT_V(6); PG8_BAR;
    }
    for (;;) {
        const bool has_next = S.next(ui + 1, nxt);
        const char* nA = has_next ? (const char*)g.A + (size_t)nxt.pm * tstep : cA; const char* nB = has_next ? (const char*)g.Bt + (size_t)nxt.pn * tstep : cB;
        for (int t = 0; t < nt; t += 2) {
            const bool last = (t == nt - 2);
            const char* a1 = cA + (size_t)(t + 1) * kstep;
            const char* a2 = last ? nA : cA + (size_t)(t + 2) * kstep; const char* b2 = last ? nB : cB + (size_t)(t + 2) * kstep;
            const char* a3 = a2 + kstep; const char* b3 = b2 + kstep;
            if constexpr (SP2) {
            PG8_LDB(B0, 0, 0); PG8_LDB(B1, 0, 1); PG8_SCHED; PG8_LDA(At, 0, 0); PG8_STAGE(PG8_SA(1, 1), a1 + hstep, voffA);
            PG8_WAIT_V(8); PG8_WAIT_L(0); PG8_BAR; PG8_MMA(0, 0, At, B0); PG8_MMA(0, 1, At, B1); PG8_BAR; PG8_SCHED;
            PG8_LDA(At, 0, 1); PG8_STAGE(PG8_SB(0, 0), b2, voffB); PG8_STAGE(PG8_SB(0, 1), b2 + hstep, voffB); PG8_STAGE(PG8_SA(0, 0), a2, voffA);
            PG8_WAIT_V(8); PG8_WAIT_L(0); PG8_BAR; PG8_MMA(1, 0, At, B0); PG8_MMA(1, 1, At, B1); PG8_BAR; PG8_SCHED;
            PG8_LDB(B0, 1, 0); PG8_LDB(B1, 1, 1); PG8_SCHED; PG8_LDA(At, 1, 0); PG8_STAGE(PG8_SA(0, 1), a2 + hstep, voffA);
            PG8_WAIT_V(8); PG8_WAIT_L(0); PG8_BAR; PG8_MMA(0, 0, At, B0); PG8_MMA(0, 1, At, B1); PG8_BAR; PG8_SCHED;
            PG8_LDA(At, 1, 1); PG8_STAGE(PG8_SB(1, 0), b3, voffB); PG8_STAGE(PG8_SB(1, 1), b3 + hstep, voffB); PG8_STAGE(PG8_SA(1, 0), a3, voffA);
            PG8_WAIT_V(8); PG8_WAIT_L(0); PG8_BAR; PG8_MMA(1, 0, At, B0); PG8_MMA(1, 1, At, B1); PG8_BAR; PG8_SCHED;
            } else {
            PG8_LDB(B0, 0, 0); PG8_SCHED; PG8_LDA(At, 0, 0); PG8_STAGE(PG8_SA(1, 1), a1 + hstep, voffA);
            PG8_WAIT_L(8); PG8_BAR; PG8_WAIT_L(0); PG8_MMA(0, 0, At, B0); PG8_BAR; PG8_SCHED;
            PG8_LDB(B1, 0, 1); PG8_STAGE(PG8_SB(0, 0), b2, voffB);
            PG8_BAR; PG8_WAIT_L(0); PG8_MMA(0, 1, At, B1); PG8_BAR;
            PG8_LDA(At, 0, 1); PG8_STAGE(PG8_SA(0, 0), a2, voffA);
            PG8_BAR; PG8_WAIT_L(0); PG8_MMA(1, 0, At, B0); PG8_BAR; PG8_SCHED;
            PG8_STAGE(PG8_SB(0, 1), b2 + hstep, voffB);
            PG8_WAIT_V(6); PG8_BAR; PG8_MMA(1, 1, At, B1); PG8_BAR;
            PG8_LDB(B0, 1, 0); PG8_SCHED; PG8_LDA(At, 1, 0); PG8_STAGE(PG8_SA(0, 1), a2 + hstep, voffA);
            PG8_WAIT_L(8); PG8_BAR; PG8_WAIT_L(0); PG8_MMA(0, 0, At, B0); PG8_BAR; PG8_SCHED;
            PG8_LDB(B1, 1, 1); PG8_STAGE(PG8_SB(1, 0), b3, voffB);
            PG8_BAR; PG8_WAIT_L(0); PG8_MMA(0, 1, At, B1); PG8_BAR;
            PG8_LDA(At, 1, 1); PG8_STAGE(PG8_SA(1, 0), a3, voffA);
            PG8_BAR; PG8_WAIT_L(0); PG8_MMA(1, 0, At, B0); PG8_BAR; PG8_SCHED;
            PG8_STAGE(PG8_SB(1, 1), b3 + hstep, voffB);
            PG8_WAIT_V(6); PG8_BAR; PG8_MMA(1, 1, At, B1); PG8_BAR;
            }
        }
        if constexpr (ALIGN_EPI) { if (wr == 0) PG8_BAR; }
        E(acc, cur, wr, wc, fr, fq);
        if (!has_next) break;
#pragma unroll
        for (int a = 0; a < 2; ++a)
#pragma unroll
            for (int b = 0; b < 2; ++b)
#pragma unroll
                for (int m = 0; m < 4; ++m)
#pragma unroll
                    for (int n = 0; n < 2; ++n) acc[a][b][m][n] = (f32x4){0.f, 0.f, 0.f, 0.f};
        cur = nxt; cA = nA; cB = nB; ++ui;
        if constexpr (ALIGN_EPI) { if (wr == 1) PG8_BAR; }
    }
    PG8_WAIT_V(0);
    if constexpr (!ALIGN_EPI) { if (wr == 0) PG8_BAR; }
    PG8_BAR;
#undef PG8_SA
#undef PG8_SB
#undef PG8_STAGE
#undef PG8_LDA
#undef PG8_LDB
#undef PG8_MMA
#undef PG8_WAIT_V
#undef PG8_WAIT_L
#undef PG8_BAR
#undef PG8_SCHED
}
}
using pg8::Unit;

#define EPI_ROWS_BEGIN _Pragma("unroll") for (int ai = 0; ai < 2; ++ai) _Pragma("unroll") for (int m = 0; m < 4; ++m) { const int row = u.pm * 256 + ai * 128 + wr * 64 + m * 16 + fr;
#define EPI_COLS_BEGIN _Pragma("unroll") for (int bj = 0; bj < 2; ++bj) { const int col = u.pn * 256 + bj * 128 + wc * 32 + 8 * fq; f32x4 v0 = acc[ai][bj][m][0], v1 = acc[ai][bj][m][1];
#define EPI_END } asm volatile("" ::: "memory"); }

struct EpiIn {
    static constexpr bool PERM = true;
    const float* ss; bf16_t *QA, *KP, *KS, *VTP, *VTS, *QKVB, *Z, *GA, *GB; float* BA;
    float *okp, *ovp, *oks, *ovs, *ogcp, *ogcs;
    __device__ __forceinline__ void operator()(const f32x4 (&acc)[2][2][4][2], const Unit& u, int wr, int wc, int fr, int fq) const {
        const int pn = u.pn;
        EPI_ROWS_BEGIN
            const float rs = rsqrtf(ss16(ss + (size_t)row * 16) * (1.f / 1024.f) + EPS);
            const bool samp = row >= TP; const int sidx = row - TP, sb = sidx >> 6, st = sidx & 63;
            EPI_COLS_BEGIN
                v0 = v0 * rs; v1 = v1 * rs;
                if (pn < 4) { st_bf8(QA + (size_t)row * 1024 + col, v0 * QSCALE, v1 * QSCALE); }
                else if (pn < 8) { const int c = col - 1024;
                    bf16_t* kb = samp ? KS + ((size_t)(sb * KVS + PAST + st)) * 1024 + c : KP + (size_t)row * 1024 + c; st_bf8(kb, v0, v1);
                    float* ko = samp ? oks + (size_t)sidx * 1024 + c : okp + (size_t)row * 1024 + c; st_f8(ko, v0, v1); }
                else if (pn < 12) { const int c = col - 2048;
                    float* vo = samp ? ovs + (size_t)sidx * 1024 + c : ovp + (size_t)row * 1024 + c; st_f8(vo, v0, v1);
                    bf16_t* vb = samp ? VTS + ((size_t)(sb * 1024 + c)) * KVS + PAST + st : VTP + (size_t)c * TP + row;
                    const size_t vp = samp ? (size_t)KVS : (size_t)TP;
#pragma unroll
                    for (int j = 0; j < 4; ++j) { vb[(size_t)j * vp] = (bf16_t)f2bf(v0[j]); vb[(size_t)(j + 4) * vp] = (bf16_t)f2bf(v1[j]); } }
                else if (pn < 24) { const int c = col - 3072; st_bf8(QKVB + (size_t)row * 3072 + c, v0, v1);
                    if (!samp && row >= TP - 3) st_f8(ogcp + (size_t)(row - (TP - 3)) * 3072 + c, v0, v1);
                    if (samp && st >= 61) st_f8(ogcs + (size_t)(sb * 3 + st - 61) * 3072 + c, v0, v1); }
                else if (pn < 28) { st_bf8(Z + (size_t)row * 1024 + (col - 6144), v0, v1); }
                else if (pn < 36) { bf16_t* gp = (pn < 32 ? GA + (col - 7168) : GB + (col - 8192)) + (size_t)row * 1024;
#pragma unroll
                    for (int j = 0; j < 4; ++j) { v0[j] = sigmoidf_(v0[j]); v1[j] = sigmoidf_(v1[j]); }
                    st_bf8(gp, v0, v1); }
                else { const int c = col - 9216; if (c < 16) st_f8(BA + (size_t)row * 16 + c, v0, v1); }
        EPI_END
    }
};
struct EpiGateA {
    static constexpr bool PERM = true;
    const bf16_t* G; float* MG;
    __device__ __forceinline__ void operator()(const f32x4 (&acc)[2][2][4][2], const Unit& u, int wr, int wc, int fr, int fq) const {
        EPI_ROWS_BEGIN EPI_COLS_BEGIN
            const size_t o = (size_t)row * 1024 + col; const u32x4 g = *(const u32x4*)(G + o);
            v0[0] *= bflo(g.x); v0[1] *= bfhi(g.x); v0[2] *= bflo(g.y); v0[3] *= bfhi(g.y); v1[0] *= bflo(g.z); v1[1] *= bfhi(g.z); v1[2] *= bflo(g.w); v1[3] *= bfhi(g.w);
            st_f8(MG + o, v0, v1);
        EPI_END
    }
};
struct EpiGateB {
    static constexpr bool PERM = true;
    const bf16_t* G; const float* MG; bf16_t* OUT;
    __device__ __forceinline__ void operator()(const f32x4 (&acc)[2][2][4][2], const Unit& u, int wr, int wc, int fr, int fq) const {
        EPI_ROWS_BEGIN EPI_COLS_BEGIN
            const size_t o = (size_t)row * 1024 + col; const u32x4 g = *(const u32x4*)(G + o);
            const f32x4 m0 = *(const f32x4*)(MG + o), m1 = *(const f32x4*)(MG + o + 4);
            v0[0] = m0[0] + v0[0] * bflo(g.x); v0[1] = m0[1] + v0[1] * bfhi(g.x); v0[2] = m0[2] + v0[2] * bflo(g.y); v0[3] = m0[3] + v0[3] * bfhi(g.y);
            v1[0] = m1[0] + v1[0] * bflo(g.z); v1[1] = m1[1] + v1[1] * bfhi(g.z); v1[2] = m1[2] + v1[2] * bflo(g.w); v1[3] = m1[3] + v1[3] * bfhi(g.w);
            st_bf8(OUT + o, v0, v1);
        EPI_END
    }
};
struct EpiRes {
    static constexpr bool PERM = true;
    float* X; const float* g; bf16_t* XN; float* ssout;
    __device__ __forceinline__ void operator()(const f32x4 (&acc)[2][2][4][2], const Unit& u, int wr, int wc, int fr, int fq) const {
        EPI_ROWS_BEGIN
            float s = 0.f;
            EPI_COLS_BEGIN
                const size_t o = (size_t)row * 1024 + col;
                v0 = v0 + *(const f32x4*)(X + o); v1 = v1 + *(const f32x4*)(X + o + 4);
                st_f8(X + o, v0, v1);
                s += (v0[0] * v0[0] + v0[1] * v0[1]) + (v0[2] * v0[2] + v0[3] * v0[3]) + (v1[0] * v1[0] + v1[1] * v1[1]) + (v1[2] * v1[2] + v1[3] * v1[3]);
                const f32x4 g0 = *(const f32x4*)(g + col), g1 = *(const f32x4*)(g + col + 4);
                st_bf8(XN + o, v0 * g0, v1 * g1);
            }
            s += __shfl_xor(s, 16); s += __shfl_xor(s, 32);
            if (fq == 0) ssout[(size_t)row * 16 + u.pn * 4 + wc] = s;
            asm volatile("" ::: "memory");
        }
    }
};
struct EpiUp {
    static constexpr bool PERM = true;
    const float* ss; bf16_t* U; float *ofcp, *ofcs;
    __device__ __forceinline__ void operator()(const f32x4 (&acc)[2][2][4][2], const Unit& u, int wr, int wc, int fr, int fq) const {
        EPI_ROWS_BEGIN
            const float rs = rsqrtf(ss16(ss + (size_t)row * 16) * (1.f / 1024.f) + EPS);
            const bool samp = row >= TP; const int sidx = row - TP, sb = sidx >> 6, st = sidx & 63;
            EPI_COLS_BEGIN
                v0 = v0 * rs; v1 = v1 * rs;
                st_bf8(U + (size_t)row * FF2 + col, v0, v1);
                if (!samp && row >= TP - 2) st_f8(ofcp + (size_t)(row - (TP - 2)) * FF2 + col, v0, v1);
                if (samp && st >= 62) st_f8(ofcs + (size_t)(sb * 2 + st - 62) * FF2 + col, v0, v1);
        EPI_END
    }
};

struct Params { const float* in[27]; float* out; unsigned char* ws; };

#define INP(i) (p.in[i])
__device__ __forceinline__ float uni(float v) { return __builtin_bit_cast(float, __builtin_amdgcn_readfirstlane(__builtin_bit_cast(int, v))); }
__device__ __forceinline__ void transpose_item(const float* src, size_t sp, bf16_t* dst, size_t dp, float* scr, int lane) {
#pragma unroll 8
    for (int i = 0; i < 32; ++i) { const int kk = 2 * i + (lane >> 5); scr[kk * 33 + (lane & 31)] = src[(size_t)kk * sp + (lane & 31)]; }
    __builtin_amdgcn_s_waitcnt(0); asm volatile("" ::: "memory");
    const int c = lane & 7;
#pragma unroll
    for (int j = 0; j < 4; ++j) { const int n = (lane >> 3) + 8 * j; const float* s = scr + (8 * c) * 33 + n;
        u32x4 o; o.x = pk2(s[0 * 33], s[1 * 33]); o.y = pk2(s[2 * 33], s[3 * 33]); o.z = pk2(s[4 * 33], s[5 * 33]); o.w = pk2(s[6 * 33], s[7 * 33]);
        *(u32x4*)(dst + (size_t)n * dp + 8 * c) = o; }
    __builtin_amdgcn_s_waitcnt(0); asm volatile("" ::: "memory");
}

constexpr int AT_SLOT = 16384, AT_Q = 4 * AT_SLOT, AT_QW = 32 * 272;
__device__ __forceinline__ void attn_unit(unsigned char* lds, const bf16_t* Qg, const bf16_t* Kg, const bf16_t* VTg, size_t vt_pitch, bf16_t* Og,
                                          int nactive, int qpos0, int ntiles, float sl2, const float* lamp, const float* subg, int wave_s, const unsigned* kmax2p) {
    const int tid = fresh_tid(wave_s);
    const int lane = tid & 63, wave = wave_s, q = lane & 31, hi = lane >> 5;
    const bool active = wave < nactive;
    const int qpos = qpos0 + 32 * wave + q;
    const int tv = active ? ((qpos0 + 32 * wave) >> 6) : -1;
    f32x16 O1[4], O2[4];
#pragma unroll
    for (int nb = 0; nb < 4; ++nb) { O1[nb] = (f32x16){}; O2[nb] = (f32x16){}; }
    float m1 = 0.f, m2 = 0.f, l1 = 0.f, l2 = 0.f;
    unsigned koff, voff;
    { const int kr = 4 * wave + (lane >> 4), kc = (lane & 15) ^ (kr & 15); koff = (unsigned)(kr * 1024 + kc * 8);
      const int vr = 16 * wave + (lane >> 2), vcx = (lane & 3) ^ ((vr >> 2) & 3); voff = (unsigned)(vr * (int)vt_pitch + vcx * 8); }
    LAS unsigned char* lds3 = (LAS unsigned char*)lds;
    const int nhalf = 2 * ntiles;
#define AT_DMA(u_) do { const int uu_ = (u_) < nhalf ? nhalf - 1 - (u_) : 0; const int sl_ = (u_) & 3; \
        __builtin_amdgcn_global_load_lds((const unsigned*)(Kg + (size_t)(koff + 32768u * (unsigned)uu_)), (LAS unsigned*)(lds3 + sl_ * AT_SLOT + wave * 1024), 16, 0, 0); \
        __builtin_amdgcn_global_load_lds((const unsigned*)(VTg + (size_t)(voff + 32u * (unsigned)uu_)), (LAS unsigned*)(lds3 + sl_ * AT_SLOT + 8192 + wave * 1024), 16, 0, 0); } while (0)
    unsigned char* Qs = lds + AT_Q + wave * AT_QW;
    const int lpk0 = (((q & 15) ^ hi) * 16) + q * 256, lpv0 = q * 64 + ((q >> 2) & 3) * 16 + 8 * hi;
    const int qaddr = AT_Q + wave * AT_QW + q * 272 + hi * 16, qd = qpos - 4 * hi;
    __syncthreads();
    {
        if (active) {
#pragma unroll
            for (int k = 0; k < 8; ++k) { const int pc = lane + 64 * k, r = pc >> 4, ch = pc & 15; *(u32x4*)(Qs + r * 272 + ch * 16) = *(const u32x4*)(Qg + (size_t)(32 * wave + r) * 1024 + ch * 8); }
        }
        asm volatile("s_waitcnt vmcnt(0) lgkmcnt(0)" ::: "memory");
        AT_DMA(0); AT_DMA(1); AT_DMA(2);
    }
    float bq1 = 0.f, bq2 = 0.f;
    if (kmax2p && active) { float s1 = 0.f, s2 = 0.f;
#pragma unroll
        for (int ch = 0; ch < 16; ++ch) { const u32x4 w = *(const u32x4*)(lds + (qaddr - hi * 16) + ch * 16);
            const float a0 = bflo(w.x), a1 = bfhi(w.x), a2 = bflo(w.y), a3 = bfhi(w.y), a4 = bflo(w.z), a5 = bfhi(w.z), a6 = bflo(w.w), a7 = bfhi(w.w);
            const float ss = (a0 * a0 + a1 * a1) + (a2 * a2 + a3 * a3) + (a4 * a4 + a5 * a5) + (a6 * a6 + a7 * a7);
            if (ch < 8) s1 += ss; else s2 += ss; }
        bq1 = sqrtf(s1) * sqrtf(__uint_as_float(kmax2p[0])) * 1.01f + 1.f; bq2 = sqrtf(s2) * sqrtf(__uint_as_float(kmax2p[1])) * 1.01f + 1.f; }
    unsigned char* flg = lds + AT_Q + 8 * AT_QW;
    for (int v = 0; v < nhalf; ++v) { const int u = nhalf - 1 - v;
        asm volatile("s_waitcnt vmcnt(4) lgkmcnt(0)\n\ts_barrier" ::: "memory");
        if (kmax2p && v > 0) { const u32x2 fv = *(const u32x2*)(flg + ((v - 1) & 1) * 8);
            const unsigned fw = fv.x & fv.y;
            if (__builtin_amdgcn_readfirstlane(fw & (fw >> 8) & (fw >> 16) & (fw >> 24) & 1u)) break; }
        AT_DMA(v + 3);
        const unsigned char* Ks = lds + (v & 3) * AT_SLOT; const unsigned char* Vs = Ks + 8192;
        const int t = u >> 1;
        if (t <= tv) {
            int lpk = lpk0, lpv = lpv0; asm volatile("" : "+v"(lpk), "+v"(lpv));
            const unsigned char* Kl = Ks; const unsigned char* Vl = Vs;
            const bool diag = (t == tv);
            {
                const float dfl = (float)(32 * u - qd);
                bf16x8 PA[2], PB[2];
#pragma unroll
                for (int mp = 0; mp < 2; ++mp) {
                    f32x16 p0 = (f32x16){};
#pragma unroll
                    for (int ds = 0; ds < 4; ++ds) {
                        const bf16x8 qf = *(const bf16x8*)(lds + qaddr + (mp * 64 + ds * 16) * 2);
                        const bf16x8 a0 = *(const bf16x8*)(Kl + (lpk ^ ((mp * 8 + ds * 2) * 16)));
                        p0 = __builtin_amdgcn_mfma_f32_32x32x16_bf16(a0, qf, p0, 0, 0, 0);
                    }
                    const float mo = mp ? m2 : m1;
                    if (!diag) { const float cm = sl2 * dfl - mo;
#pragma unroll
                        for (int r = 0; r < 16; ++r) p0[r] = fmaf(sl2, (float)((r & 3) + 8 * (r >> 2)), p0[r]) + cm;
                    } else {
#pragma unroll
                        for (int r = 0; r < 16; ++r) p0[r] = p0[r] - sl2 * fabsf(dfl + (float)((r & 3) + 8 * (r >> 2))) - mo;
                    }
                    float mx = fmaxf(fmaxf(p0[0], p0[1]), p0[2]);
#pragma unroll
                    for (int r = 3; r < 15; r += 2) mx = fmaxf(fmaxf(mx, p0[r]), p0[r + 1]);
                    mx = fmaxf(mx, p0[15]);
                    { auto rr = __builtin_amdgcn_permlane32_swap(__float_as_uint(mx), __float_as_uint(mx), false, false); mx = fmaxf(__uint_as_float(rr[0]), __uint_as_float(rr[1])); }
                    const bool first = (u == 2 * tv + 1);
                    if (first || __any(mx > 8.f)) {
                        const float dl = first ? mx : fmaxf(mx, 0.f);
#pragma unroll
                        for (int r = 0; r < 16; ++r) p0[r] -= dl;
                        if (!first) { const float al = __builtin_amdgcn_exp2f(-dl);
                            if (mp == 0) { l1 *= al;
#pragma unroll
                                for (int nb = 0; nb < 4; ++nb) O1[nb] = O1[nb] * al; }
                            else { l2 *= al;
#pragma unroll
                                for (int nb = 0; nb < 4; ++nb) O2[nb] = O2[nb] * al; } }
                        if (mp == 0) m1 = mo + dl; else m2 = mo + dl;
                    }
                    float rsum = 0.f;
#pragma unroll
                    for (int r = 0; r < 16; ++r) { p0[r] = __builtin_amdgcn_exp2f(p0[r]); rsum += p0[r]; }
                    if (mp == 0) { l1 += rsum; PA[0] = pack8(p0[0], p0[1], p0[2], p0[3], p0[4], p0[5], p0[6], p0[7]); PA[1] = pack8(p0[8], p0[9], p0[10], p0[11], p0[12], p0[13], p0[14], p0[15]); }
                    else { l2 += rsum; PB[0] = pack8(p0[0], p0[1], p0[2], p0[3], p0[4], p0[5], p0[6], p0[7]); PB[1] = pack8(p0[8], p0[9], p0[10], p0[11], p0[12], p0[13], p0[14], p0[15]); }
                }
#pragma unroll
                for (int nb = 0; nb < 4; ++nb) {
#pragma unroll
                    for (int jj = 0; jj < 2; ++jj) { const unsigned char* vp = Vl + nb * 2048;
                        const s16x4 lo = *(const s16x4*)(vp + (lpv ^ ((2 * jj) * 16))), hh = *(const s16x4*)(vp + (lpv ^ ((2 * jj + 1) * 16)));
                        const bf16x8 vf = (bf16x8){lo[0], lo[1], lo[2], lo[3], hh[0], hh[1], hh[2], hh[3]};
                        O1[nb] = __builtin_amdgcn_mfma_f32_32x32x16_bf16(vf, PA[jj], O1[nb], 0, 0, 0);
                        O2[nb] = __builtin_amdgcn_mfma_f32_32x32x16_bf16(vf, PB[jj], O2[nb], 0, 0, 0); }
                    asm volatile("" : "+v"(O1[nb]), "+v"(O2[nb])); __builtin_amdgcn_sched_barrier(0); }
                asm volatile("" ::: "memory");
            }
        }
        if (kmax2p) {
            bool negl = true;
            if (active) { const float dist = (float)(qd + 4 * hi - 32 * u + 1);
                negl = (u <= 2 * tv + 1) && (dist > 0.f) && (bq1 - sl2 * dist - m1 < -48.f) && (bq2 - sl2 * dist - m2 < -48.f); }
            const bool wv = __all(negl);
            if (lane == 0) flg[(v & 1) * 8 + wave] = wv ? 1 : 0;
        }
    }
#undef AT_DMA
    if (active) {
        const int tid2 = fresh_tid(wave_s);
        const int q = tid2 & 31, hi = (tid2 >> 5) & 1;
        l1 += __shfl_xor(l1, 32); l2 += __shfl_xor(l2, 32);
        const float lam = lamp[0], oscale = lamp[1];
        const float i1 = 1.f / l1, i2 = lam / l2; float ssq = 0.f;
#pragma unroll
        for (int nb = 0; nb < 4; ++nb)
#pragma unroll
            for (int r = 0; r < 16; ++r) { const float od = O1[nb][r] * i1 - O2[nb][r] * i2; O1[nb][r] = od; ssq += od * od; }
        ssq += __shfl_xor(ssq, 32);
        const float rn = rsqrtf(ssq * (1.f / 128.f) + EPS) * oscale;
        bf16_t* orow = Og + (size_t)(32 * wave + q) * 1024;
#pragma unroll
        for (int nb = 0; nb < 4; ++nb)
#pragma unroll
            for (int rg = 0; rg < 4; ++rg) { const int dv0 = 32 * nb + 8 * rg + 4 * hi; const f32x4 g = *(const f32x4*)(subg + dv0);
                u32x2 w; w.x = pk2(O1[nb][4 * rg] * rn * g[0], O1[nb][4 * rg + 1] * rn * g[1]); w.y = pk2(O1[nb][4 * rg + 2] * rn * g[2], O1[nb][4 * rg + 3] * rn * g[3]);
                *(u32x2*)(orow + dv0) = w; }
    }
    __syncthreads();
}

constexpr int GP_LM = 0, GP_AT = 64 * 64 * 4, GP_SM = GP_AT + 64 * 65 * 4, GP_QC = GP_SM + 1024, GP_KC = GP_QC + 64 * 129 * 4, GP_VC = GP_KC + 64 * 129 * 4;
__device__ __forceinline__ void gdn_prep_unit(unsigned char* lds, const Params& p, int l, int ch, int h, int wave_s) {
    const int tid = fresh_tid(wave_s);
    const int lane = tid & 63, wave = wave_s;
    float* qc = (float*)(lds + GP_QC); float* kc = (float*)(lds + GP_KC); float* vc = (float*)(lds + GP_VC); float* Lm = (float*)(lds + GP_LM); float* AT = (float*)(lds + GP_AT);
    float* sG = (float*)(lds + GP_SM); float* sB = sG + 64; float* sRq = sG + 128; float* sRk = sG + 192;
    const bf16_t* QKVB = (const bf16_t*)(p.ws + WS_QKVB); const float* BA = (const float*)(p.ws + WS_BA);
    unsigned char* blob = p.ws + WS_GDNP + (size_t)(h * 264 + ch) * BLOB;
    const int m0 = ch * 64; const bool samp = ch >= 256; const int sb = ch - 256;
    __syncthreads();
    if (tid < 384) {
        const int part = tid >> 7, c = tid & 127;
        const int col = (part == 0 ? 2048 : (part == 1 ? 1024 : 0)) + h * 128 + c;
        float* dstc = (part == 0 ? vc : (part == 1 ? kc : qc)) + c;
        const float* cw = INP(14) + (size_t)l * 4 * 3072 + col;
        const float w0 = cw[0], w1 = cw[3072], w2 = cw[2 * 3072], w3 = cw[3 * 3072];
        float x3, x2, x1;
        if (samp) { const float* sc = INP(5) + ((size_t)(l * 8 + sb) * 3) * 3072 + col; x3 = sc[0]; x2 = sc[3072]; x1 = sc[2 * 3072]; }
        else if (ch == 0) { x3 = 0.f; x2 = 0.f; x1 = 0.f; }
        else { const bf16_t* pr = QKVB + (size_t)(m0 - 3) * 3072 + col; x3 = bf2f(pr[0]); x2 = bf2f(pr[3072]); x1 = bf2f(pr[2 * 3072]); }
        const bf16_t* xp = QKVB + (size_t)m0 * 3072 + col;
        bf16_t raw[64];
#pragma unroll
        for (int i = 0; i < 64; ++i) raw[i] = xp[(size_t)i * 3072];
#pragma unroll
        for (int i = 0; i < 64; ++i) {
            const float x0 = bf2f(raw[i]);
            float y = w0 * x3 + w1 * x2 + w2 * x1 + w3 * x0; y = siluf_(y);
            x3 = x2; x2 = x1; x1 = x0;
            dstc[i * 129] = y;
        }
    } else if (tid < 448) {
        const int i = tid - 384;
        const float braw = BA[(size_t)(m0 + i) * 16 + h], araw = BA[(size_t)(m0 + i) * 16 + 8 + h];
        const float xx = araw + INP(16)[l * 8 + h];
        const float sp = xx > 20.f ? xx : log1pf(__expf(xx));
        float G = -__expf(INP(15)[l * 8 + h]) * sp;
#pragma unroll
        for (int o = 1; o < 64; o <<= 1) { const float tt = __shfl_up(G, o); if (i >= o) G += tt; }
        sG[i] = G; sB[i] = sigmoidf_(braw);
    }
    __syncthreads();
    {
#pragma unroll
        for (int rr = 0; rr < 8; ++rr) { const int row = wave * 8 + rr;
            const float a = qc[row * 129 + lane], b = qc[row * 129 + 64 + lane], c2 = kc[row * 129 + lane], d2 = kc[row * 129 + 64 + lane];
            const float sq = wave_sum(a * a + b * b), sk = wave_sum(c2 * c2 + d2 * d2);
            if (lane == 0) { sRq[row] = rsqrtf(sq + EPS) * 0.08838834764831845f; sRk[row] = rsqrtf(sk + EPS); } }
    }
    __syncthreads();
    {
        const int fi = lane & 15, fk = lane >> 4;
#pragma unroll 1
        for (int tt = 0; tt < 4; ++tt) {
            const int tile = wave * 4 + tt, isq = tile >> 4, ti = (tile >> 2) & 3, tj = tile & 3;
            if (ti < tj) continue;
            const float* X = isq ? qc : kc;
            f32x4 d = (f32x4){0.f, 0.f, 0.f, 0.f};
#pragma unroll 8
            for (int s = 0; s < 32; ++s) {
                const float a = X[(16 * ti + fi) * 129 + 4 * s + fk], b = kc[(16 * tj + fi) * 129 + 4 * s + fk];
                d = __builtin_amdgcn_mfma_f32_16x16x4f32(a, b, d, 0, 0, 0);
            }
            const int j = 16 * tj + fi; const float gj = sG[j], rkj = sRk[j];
#pragma unroll
            for (int r = 0; r < 4; ++r) { const int i = 16 * ti + 4 * fk + r; const float gi = sG[i];
                const float dec = __expf(fminf(gi - gj, 0.f));
                if (isq) AT[i * 65 + j] = (i >= j) ? sRq[i] * rkj * d[r] * dec : 0.f;
                else Lm[i * 64 + j] = (i > j) ? sB[i] * sRk[i] * rkj * d[r] * dec : 0.f; }
        }
        for (int e = tid; e < 64 * 64; e += 512) { const int i = e >> 6, j = e & 63; if ((i >> 4) < (j >> 4)) { Lm[i * 64 + j] = 0.f; AT[i * 65 + j] = 0.f; } }
    }
    __syncthreads();
    const float glast = sG[63];
    if (tid < 256) {
        float xr[64];
        if (tid < 128) {
#pragma unroll
            for (int i = 0; i < 64; ++i) xr[i] = vc[i * 129 + tid] * sB[i];
        } else {
#pragma unroll
            for (int i = 0; i < 64; ++i) xr[i] = kc[i * 129 + tid - 128] * sB[i] * sRk[i] * __expf(sG[i]);
        }
#pragma unroll
        for (int i = 1; i < 64; ++i) {
            float a0 = 0.f, a1 = 0.f, a2 = 0.f, a3 = 0.f;
#pragma unroll
            for (int j4 = 0; j4 < (i + 3) / 4; ++j4) { const f32x4 lv = *(const f32x4*)(Lm + i * 64 + 4 * j4);
                a0 += lv[0] * xr[4 * j4]; if (4 * j4 + 1 < i) a1 += lv[1] * xr[4 * j4 + 1]; if (4 * j4 + 2 < i) a2 += lv[2] * xr[4 * j4 + 2]; if (4 * j4 + 3 < i) a3 += lv[3] * xr[4 * j4 + 3]; }
            xr[i] -= (a0 + a1) + (a2 + a3);
        }
        if (tid < 128) {
            const int v = tid, w = v >> 5, n = v & 31; float* U = (float*)(blob + BLOB_U);
#pragma unroll
            for (int tile = 0; tile < 2; ++tile)
#pragma unroll
                for (int a8 = 0; a8 < 4; ++a8)
#pragma unroll
                    for (int hh = 0; hh < 2; ++hh) { const int c0 = 32 * tile + 8 * a8 + 4 * hh;
                        *(f32x4*)(U + ((size_t)((w * 2 + tile) * 64 + hh * 32 + n)) * 16 + 4 * a8) = (f32x4){xr[c0], xr[c0 + 1], xr[c0 + 2], xr[c0 + 3]}; }
        } else {
            const int k = tid - 128, s = k >> 4, kk = k & 15, hh = (kk >> 2) & 1, j = (kk & 3) + 4 * (kk >> 3); bf16_t* W = (bf16_t*)blob;
#pragma unroll
            for (int c = 0; c < 64; ++c) { const int i = c >> 5, mrow = c & 31; W[(size_t)(((i * 8 + s) * 64 + hh * 32 + mrow)) * 8 + j] = (bf16_t)f2bf(-xr[c]); }
        }
    } else {
        const int t2 = tid - 256;
#pragma unroll 1
        for (int pc = t2; pc < 1024; pc += 256) { const int f = pc >> 6, ll = pc & 63, i = f >> 3, s = f & 7, row = 32 * i + (ll & 31), hh = ll >> 5;
            const float sc = sRq[row] * __expf(sG[row]); float vv[8];
#pragma unroll
            for (int j = 0; j < 8; ++j) vv[j] = qc[row * 129 + 16 * s + (j & 3) + 8 * (j >> 2) + 4 * hh] * sc;
            *(bf16x8*)(blob + 16384 + (size_t)pc * 16) = pack8(vv[0], vv[1], vv[2], vv[3], vv[4], vv[5], vv[6], vv[7]); }
#pragma unroll 1
        for (int pc = t2; pc < 512; pc += 256) { const int f = pc >> 6, ll = pc & 63, i = f >> 2, s = f & 3, row = 32 * i + (ll & 31), hh = ll >> 5; float vv[8];
#pragma unroll
            for (int j = 0; j < 8; ++j) vv[j] = AT[row * 65 + 16 * s + (j & 3) + 8 * (j >> 2) + 4 * hh];
            *(bf16x8*)(blob + 32768 + (size_t)pc * 16) = pack8(vv[0], vv[1], vv[2], vv[3], vv[4], vv[5], vv[6], vv[7]); }
#pragma unroll 1
        for (int pc = t2; pc < 1024; pc += 256) { const int f = pc >> 6, ll = pc & 63, kt = f >> 2, s = f & 3, krow = 32 * kt + (ll & 31), hh = ll >> 5; float vv[8];
#pragma unroll
            for (int j = 0; j < 8; ++j) { const int c = 16 * s + (j & 3) + 8 * (j >> 2) + 4 * hh; vv[j] = kc[c * 129 + krow] * sRk[c] * __expf(glast - sG[c]); }
            *(bf16x8*)(blob + 40960 + (size_t)pc * 16) = pack8(vv[0], vv[1], vv[2], vv[3], vv[4], vv[5], vv[6], vv[7]); }
        if (t2 == 0) *(float*)(blob + BLOB_EG) = __expf(glast);
    }
    asm volatile("s_waitcnt vmcnt(0)" ::: "memory");
    __syncthreads();
    if (tid == 0) { __builtin_amdgcn_fence(__ATOMIC_RELEASE, "agent");
        __hip_atomic_store((unsigned*)(p.ws + WS_CTL) + 8192 + l * 2112 + h * 264 + ch, 1u, __ATOMIC_RELAXED, __HIP_MEMORY_SCOPE_AGENT); }
}

constexpr int SC_OT = 2 * BLOB_A;
__device__ __forceinline__ void gdn_scan_unit(unsigned char* lds, unsigned char* ws, const float* gn, int ch0, int nsteps, int h, const float* S0, float* Sout, int wave_s, unsigned* rdy) {
    const int tid = fresh_tid(wave_s);
    const int lane = tid & 63, wave = wave_s, n = lane & 31, hi = lane >> 5;
    const unsigned char* blob0 = ws + WS_GDNP + (size_t)(h * 264 + ch0) * BLOB;
    const size_t bstep = (size_t)BLOB;
    float* ot = (float*)(lds + SC_OT);
    const bf16_t* Z = (const bf16_t*)(ws + WS_Z); bf16_t* OB = (bf16_t*)(ws + WS_OB);
#define SC_WAITRDY(a_, b_) do { if (tid == 0) { for (int k_ = (a_); k_ < (b_); ++k_) { unsigned sp_ = 0; \
            while (__hip_atomic_load(rdy + k_, __ATOMIC_RELAXED, __HIP_MEMORY_SCOPE_AGENT) == 0u) { __builtin_amdgcn_s_sleep(8); if (++sp_ > (1u << 24)) break; } } } \
        asm volatile("s_waitcnt vmcnt(0) lgkmcnt(0)" ::: "memory"); __builtin_amdgcn_s_barrier(); asm volatile("" ::: "memory"); \
        __builtin_amdgcn_fence(__ATOMIC_ACQUIRE, "agent"); } while (0)
    __syncthreads();
    SC_WAITRDY(0, nsteps < 32 ? nsteps : 32);
    LAS unsigned char* lds3 = (LAS unsigned char*)lds;
#define SC_DMA(src_, stage_) do { _Pragma("unroll") for (int k_ = 0; k_ < 14; ++k_) \
        __builtin_amdgcn_global_load_lds((const unsigned*)((src_) + (size_t)(((wave - 4) * 14 + k_) * 1024) + (unsigned)(lane * 16)), \
            (LAS unsigned*)(lds3 + (stage_) * BLOB_A + ((wave - 4) * 14 + k_) * 1024), 16, 0, 0); } while (0)
#define SC_BS(s) pack8(S[(s) >> 1][8 * ((s) & 1)], S[(s) >> 1][8 * ((s) & 1) + 1], S[(s) >> 1][8 * ((s) & 1) + 2], S[(s) >> 1][8 * ((s) & 1) + 3], S[(s) >> 1][8 * ((s) & 1) + 4], S[(s) >> 1][8 * ((s) & 1) + 5], S[(s) >> 1][8 * ((s) & 1) + 6], S[(s) >> 1][8 * ((s) & 1) + 7])
#define SC_NORM(cc, zz) do { const size_t mb_ = ((size_t)(ch0 + (cc)) * 64) * 1024 + h * 128; \
        float ssq_ = 0.f; \
        _Pragma("unroll") for (int k = 0; k < 8; ++k) { const f32x4 t4 = *(const f32x4*)(ot + nrow * 132 + 32 * nqd + 4 * k); ssq_ += (t4[0] * t4[0] + t4[1] * t4[1]) + (t4[2] * t4[2] + t4[3] * t4[3]); } \
        ssq_ += __shfl_xor(ssq_, 1); ssq_ += __shfl_xor(ssq_, 2); \
        const float rstd = rsqrtf(ssq_ * (1.f / 128.f) + EPS); bf16_t* op = OB + mb_ + nmoff; \
        _Pragma("unroll") for (int k = 0; k < 4; ++k) { const float* gg = gq + 8 * k; \
            const f32x4 oa = *(const f32x4*)(ot + nrow * 132 + 32 * nqd + 8 * k), ob = *(const f32x4*)(ot + nrow * 132 + 32 * nqd + 8 * k + 4); \
            u32x4 w; w.x = pk2(oa[0] * rstd * gg[0] * siluf_(bflo(zz[k].x)), oa[1] * rstd * gg[1] * siluf_(bfhi(zz[k].x))); \
            w.y = pk2(oa[2] * rstd * gg[2] * siluf_(bflo(zz[k].y)), oa[3] * rstd * gg[3] * siluf_(bfhi(zz[k].y))); \
            w.z = pk2(ob[0] * rstd * gg[4] * siluf_(bflo(zz[k].z)), ob[1] * rstd * gg[5] * siluf_(bfhi(zz[k].z))); \
            w.w = pk2(ob[2] * rstd * gg[6] * siluf_(bflo(zz[k].w)), ob[3] * rstd * gg[7] * siluf_(bfhi(zz[k].w))); \
            *(GAS u32x4*)(op + 8 * k) = w; } } while (0)
    if (wave < 4) {
        f32x16 S[4], Ua[2]; float ega = 0.f;
#pragma unroll
        for (int kt = 0; kt < 4; ++kt)
#pragma unroll
            for (int r = 0; r < 16; ++r) S[kt][r] = S0 ? S0[(size_t)(32 * kt + crow(r, hi)) * 128 + 32 * wave + n] : 0.f;
#define SC_ULD(UR, EG, cc) do { const unsigned char* ub_ = blob0 + (size_t)(cc) * bstep; \
            _Pragma("unroll") for (int i = 0; i < 2; ++i) UR[i] = *(const GAS f32x16*)(ub_ + (size_t)(BLOB_U + (wave * 2 + i) * 4096) + (unsigned)(lane * 64)); \
            EG = *(const GAS float*)(ub_ + BLOB_EG); } while (0)
#define SC_LDP12(F, s_) do { F[0] = *(const bf16x8*)(Al + ((s_)) * 1024); F[1] = *(const bf16x8*)(Al + (8 + (s_)) * 1024); F[2] = *(const bf16x8*)(Al + 16384 + ((s_)) * 1024); F[3] = *(const bf16x8*)(Al + 16384 + (8 + (s_)) * 1024); } while (0)
#define SC_LDROW(F, base_, f0_) do { _Pragma("unroll") for (int j_ = 0; j_ < 4; ++j_) F[j_] = *(const bf16x8*)(Al + (base_) + ((f0_) + j_) * 1024); } while (0)
#define SC_G12(s_, CUR, NXT, LOADNEXT) do { LOADNEXT; __builtin_amdgcn_sched_barrier(0); { const bf16x8 bs = SC_BS(s_); \
            vn[0] = __builtin_amdgcn_mfma_f32_32x32x16_bf16(CUR[0], bs, vn[0], 0, 0, 0); vn[1] = __builtin_amdgcn_mfma_f32_32x32x16_bf16(CUR[1], bs, vn[1], 0, 0, 0); \
            o[0] = __builtin_amdgcn_mfma_f32_32x32x16_bf16(CUR[2], bs, o[0], 0, 0, 0); o[1] = __builtin_amdgcn_mfma_f32_32x32x16_bf16(CUR[3], bs, o[1], 0, 0, 0); } \
            asm volatile("" : "+v"(vn[0]), "+v"(vn[1]), "+v"(o[0]), "+v"(o[1])); __builtin_amdgcn_sched_barrier(0); } while (0)
#define SC_GROW(ACC, CUR, NXT, LOADNEXT) do { LOADNEXT; __builtin_amdgcn_sched_barrier(0); \
            _Pragma("unroll") for (int j_ = 0; j_ < 4; ++j_) ACC = __builtin_amdgcn_mfma_f32_32x32x16_bf16(CUR[j_], bV[j_], ACC, 0, 0, 0); \
            asm volatile("" : "+v"(ACC)); __builtin_amdgcn_sched_barrier(0); } while (0)
#define SC_CSTEP(c, UR, EG) do { \
            const unsigned char* A = lds + ((c) & 1) * BLOB_A; \
            const float eg = EG; \
            f32x16 vn[2]; vn[0] = UR[0]; vn[1] = UR[1]; \
            if ((c) + 1 < nsteps) SC_ULD(UR, EG, (c) + 1); \
              \
            const unsigned char* Al = A + lane * 16; \
            bf16x8 F0[4], F1[4]; f32x16 o[2]; o[0] = (f32x16){}; o[1] = (f32x16){}; \
            SC_LDP12(F0, 0); \
            SC_G12(0, F0, F1, SC_LDP12(F1, 1)); SC_G12(1, F1, F0, SC_LDP12(F0, 2)); SC_G12(2, F0, F1, SC_LDP12(F1, 3)); SC_G12(3, F1, F0, SC_LDP12(F0, 4)); \
            SC_G12(4, F0, F1, SC_LDP12(F1, 5)); SC_G12(5, F1, F0, SC_LDP12(F0, 6)); SC_G12(6, F0, F1, SC_LDP12(F1, 7)); SC_G12(7, F1, F0, SC_LDROW(F0, 32768, 0)); \
            bf16x8 bV[4]; \
            _Pragma("unroll") for (int s = 0; s < 4; ++s) { const int i = s >> 1, b = 8 * (s & 1); \
                bV[s] = pack8(vn[i][b], vn[i][b + 1], vn[i][b + 2], vn[i][b + 3], vn[i][b + 4], vn[i][b + 5], vn[i][b + 6], vn[i][b + 7]); } \
            SC_GROW(o[0], F0, F1, SC_LDROW(F1, 32768, 4)); \
            SC_GROW(o[1], F1, F0, SC_LDROW(F0, 40960, 0)); \
            S[0] = S[0] * eg; SC_GROW(S[0], F0, F1, SC_LDROW(F1, 40960, 4)); \
            S[1] = S[1] * eg; SC_GROW(S[1], F1, F0, SC_LDROW(F0, 40960, 8)); \
            S[2] = S[2] * eg; SC_GROW(S[2], F0, F1, SC_LDROW(F1, 40960, 12)); \
            S[3] = S[3] * eg; SC_GROW(S[3], F1, F0, (void)0); \
            asm volatile("s_waitcnt lgkmcnt(0)\n\ts_barrier" ::: "memory");     \
            _Pragma("unroll") for (int i = 0; i < 2; ++i) \
                _Pragma("unroll") for (int r = 0; r < 16; ++r) ot[(32 * i + crow(r, hi)) * 132 + 32 * wave + n] = o[i][r]; \
            asm volatile("s_waitcnt lgkmcnt(0)\n\ts_barrier" ::: "memory");     \
        } while (0)
        SC_ULD(Ua, ega, 0);
        __syncthreads();
        for (int c = 0; c < nsteps; c += 4) {
            if ((c & 31) == 16 && c + 16 < nsteps) SC_WAITRDY(c + 16, c + 48 < nsteps ? c + 48 : nsteps);
            SC_CSTEP(c, Ua, ega);
            if (c + 1 < nsteps) SC_CSTEP(c + 1, Ua, ega);
            if (c + 2 < nsteps) SC_CSTEP(c + 2, Ua, ega);
            if (c + 3 < nsteps) SC_CSTEP(c + 3, Ua, ega);
        }
#undef SC_ULD
#undef SC_CSTEP
        { const int t3 = fresh_tid(wave_s), n3 = t3 & 31, hi3 = (t3 >> 5) & 1;
#pragma unroll
        for (int kt = 0; kt < 4; ++kt)
#pragma unroll
            for (int r = 0; r < 16; ++r) Sout[(size_t)(32 * kt + crow(r, hi3)) * 128 + 32 * wave + n3] = S[kt][r]; }
    } else {
        const int lt = tid - 256, nrow = lt >> 2, nqd = lt & 3; const unsigned nmoff = (unsigned)(nrow * 1024 + 32 * nqd);
        u32x4 zn[4];
        float* gq = (float*)(lds + SC_OT + 64 * 132 * 4) + 32 * nqd;
        if (lt < 128) ((float*)(lds + SC_OT + 64 * 132 * 4))[lt] = gn[lt];
        u32x4 pa[14], pb[14];
        const unsigned lo16 = (unsigned)lt * 16u;
#define SC_LD(dst, cc) do { const unsigned char* sb_ = blob0 + (size_t)(cc) * bstep; _Pragma("unroll") for (int k_ = 0; k_ < 14; ++k_) dst[k_] = *(const GAS u32x4*)(sb_ + (size_t)(4096 * k_) + lo16); } while (0)
#define SC_ST(src, stage_) do { unsigned char* sd_ = lds + (stage_) * BLOB_A; _Pragma("unroll") for (int k_ = 0; k_ < 14; ++k_) *(u32x4*)(sd_ + lo16 + 4096 * k_) = src[k_]; } while (0)
#define SC_STEP(c, PREG) do { \
            u32x4 zc[4]; \
            _Pragma("unroll") for (int k = 0; k < 4; ++k) zc[k] = zn[k]; \
            { const bf16_t* zp = Z + ((size_t)(ch0 + (c)) * 64) * 1024 + h * 128 + nmoff; \
              _Pragma("unroll") for (int k = 0; k < 4; ++k) zn[k] = *(const GAS u32x4*)(zp + 8 * k); } \
            if ((c) + 1 < nsteps) SC_ST(PREG, ((c) + 1) & 1);          \
            if ((c) + 3 < nsteps) SC_LD(PREG, (c) + 3);                 \
            if ((c) > 0) SC_NORM((c) - 1, zc); \
            asm volatile("s_waitcnt lgkmcnt(0)\n\ts_barrier" ::: "memory");     \
            asm volatile("s_waitcnt lgkmcnt(0)\n\ts_barrier" ::: "memory");     \
        } while (0)
        SC_DMA(blob0, 0);
        if (1 < nsteps) SC_LD(pa, 1);
        if (2 < nsteps) SC_LD(pb, 2);
        __syncthreads();
        for (int c = 0; c < nsteps; c += 8) {
            if ((c & 31) == 16 && c + 16 < nsteps) SC_WAITRDY(c + 16, c + 48 < nsteps ? c + 48 : nsteps);
            SC_STEP(c, pa);
            if (c + 1 < nsteps) SC_STEP(c + 1, pb);
            if (c + 2 < nsteps) SC_STEP(c + 2, pa);
            if (c + 3 < nsteps) SC_STEP(c + 3, pb);
            if (c + 4 < nsteps) SC_STEP(c + 4, pa);
            if (c + 5 < nsteps) SC_STEP(c + 5, pb);
            if (c + 6 < nsteps) SC_STEP(c + 6, pa);
            if (c + 7 < nsteps) SC_STEP(c + 7, pb);
        }
#undef SC_LD
#undef SC_ST
#undef SC_STEP
        SC_NORM(nsteps - 1, zn);
    }
    __syncthreads();
#undef SC_WAITRDY
#undef SC_DMA
#undef SC_BS
#undef SC_NORM
}


#define XB_TMO      128
#define XB_XCNT(j)  (256  + 64 * (j))
#define XB_XSUB(j)  (1280 + 64 * (j))
#define XB_XGEN(j)  (2304 + 64 * (j))
#define XB_TOP      3328
#define XB_TOPGEN   3392
#define XCD_BAR_WORDS 3456
#define XB_SPIN_CAP (1u << 18)
__device__ __forceinline__ unsigned xb_ld(unsigned* p)              { return __hip_atomic_load(p, __ATOMIC_RELAXED, __HIP_MEMORY_SCOPE_AGENT); }
__device__ __forceinline__ unsigned xb_add(unsigned* p, unsigned v) { return __hip_atomic_fetch_add(p, v, __ATOMIC_RELAXED, __HIP_MEMORY_SCOPE_AGENT); }
__device__ __forceinline__ unsigned xb_xcc_id() { return (unsigned)__builtin_amdgcn_s_getreg((3 << 11) | 20) & 0xFu; }
#define XB_SPIN(cond, bar) do { unsigned _sp = 0; while (cond) { __builtin_amdgcn_s_sleep(1); \
    if ((++_sp & 255u) == 0u) { if (xb_ld(&(bar)[XB_TMO])) break; if (_sp > XB_SPIN_CAP) { atomicAdd(&(bar)[XB_TMO], 1u); break; } } } } while (0)
struct XcdBarrier { unsigned* bar; unsigned x; volatile LAS unsigned* st; };
__device__ __forceinline__ XcdBarrier xcd_barrier_post(unsigned* bar, volatile LAS unsigned* st, bool leader) {
    XcdBarrier b; b.bar = bar; b.x = xb_xcc_id(); b.st = st;
    if (leader) (void)xb_add(&bar[XB_XCNT(b.x)], 1u);
    return b;
}
__device__ __forceinline__ void xcd_barrier_complete(unsigned* bar, unsigned x, unsigned& nloc, unsigned& nx) {
    const unsigned G = gridDim.x * gridDim.y * gridDim.z;
    unsigned sum, cnt, mine, sp = 0u;
    for (;;) {
        sum = 0u; cnt = 0u; mine = 0u;
#pragma unroll
        for (unsigned j = 0; j < 16; ++j) { const unsigned c = xb_ld(&bar[XB_XCNT(j)]); sum += c; cnt += (c > 0u) ? 1u : 0u; mine = (j == x) ? c : mine; }
        if (sum == G) break;
        __builtin_amdgcn_s_sleep(1);
        if ((++sp & 255u) == 0u) { if (xb_ld(&bar[XB_TMO])) break; if (sp > XB_SPIN_CAP) { atomicAdd(&bar[XB_TMO], 1u); break; } }
    }
    nloc = mine > 0u ? mine : 1u; nx = cnt > 0u ? cnt : 1u;
}
__device__ __forceinline__ void xcd_barrier(const XcdBarrier& b, bool leader) {
    asm volatile("s_waitcnt vmcnt(0)" ::: "memory");
    __syncthreads();
    if (leader) {
        unsigned* bar = b.bar;
        __builtin_amdgcn_s_waitcnt(0);
        unsigned nloc = b.st[0], nx = b.st[1];
        if (nloc == 0u) { xcd_barrier_complete(bar, b.x, nloc, nx); b.st[0] = nloc; b.st[1] = nx; }
        const unsigned old = xb_add(&bar[XB_XSUB(b.x)], 1u);
        const unsigned gen = old / nloc;
        if (old + 1u == (gen + 1u) * nloc) {
            __builtin_amdgcn_fence(__ATOMIC_RELEASE, "agent");
            asm volatile("s_waitcnt vmcnt(0)" ::: "memory");
            const unsigned og = xb_add(&bar[XB_TOP], 1u);
            const unsigned tg = og / nx;
            if (og + 1u == (tg + 1u) * nx) xb_add(&bar[XB_TOPGEN], 1u);
            else XB_SPIN(xb_ld(&bar[XB_TOPGEN]) == tg, bar);
            __builtin_amdgcn_fence(__ATOMIC_ACQUIRE, "agent");
            xb_add(&bar[XB_XGEN(b.x)], 1u);
            asm volatile("s_waitcnt vmcnt(0)" ::: "memory");
        } else {
            XB_SPIN(xb_ld(&bar[XB_XGEN(b.x)]) == gen, bar);
            __builtin_amdgcn_fence(__ATOMIC_ACQUIRE, "agent");
            asm volatile("s_waitcnt vmcnt(0)" ::: "memory");
        }
    }
    __syncthreads();
}
#define IDS const int tid = fresh_tid(wave_s); const int lane = tid & 63, wave = wave_s; const int gw = bid * 8 + wave; const size_t gtid = (size_t)bid * 512 + tid; (void)lane; (void)gw; (void)gtid;
#define GSYNC() xcd_barrier(xbar, fresh_tid(wave_s) == 0)
template <int l>
__device__ __forceinline__ void layer_body(const Params& p, unsigned char* lds, int* s_item_p, int wave_s, const XcdBarrier& xbar) {
    const int G = gridDim.x, bid = blockIdx.x;
    const int NGW = G * 8; const size_t NGT = (size_t)G * 512;
#define PHASE_WS unsigned char* ws = p.ws; asm volatile("" : "+s"(ws)); float* outp = p.out; asm volatile("" : "+s"(outp)); unsigned* ctl = (unsigned*)(ws + WS_CTL); float* ssq = (float*)(ws + WS_SSP); float* X = (float*)(ws + WS_X); bf16_t* XN = (bf16_t*)(ws + WS_XN); unsigned char* wl = ws + WS_W + (size_t)l * W_LSTRIDE; (void)ctl; (void)ssq; (void)X; (void)XN; (void)wl; (void)outp;
    LAS unsigned char* lds3 = (LAS unsigned char*)lds;
    (void)NGW; (void)NGT;
#define s_item (*s_item_p)
        {
            PHASE_WS
            pg8::Gemm g{XN, (const bf16_t*)wl, M, NIN, 1024}; pg8::StaticOrder S; S.init(M, NIN, G, bid);
            EpiIn E; E.ss = ssq + (size_t)(2 * l) * M * 16; E.QA = (bf16_t*)(ws + WS_QA); E.KP = (bf16_t*)(ws + WS_KP); E.KS = (bf16_t*)(ws + WS_KS); E.VTP = (bf16_t*)(ws + WS_VTP); E.VTS = (bf16_t*)(ws + WS_VTS);
            E.QKVB = (bf16_t*)(ws + WS_QKVB); E.Z = (bf16_t*)(ws + WS_Z); E.GA = (bf16_t*)(ws + WS_GA); E.GB = (bf16_t*)(ws + WS_GB); E.BA = (float*)(ws + WS_BA);
            E.okp = outp + O_KP + (size_t)l * 16777216; E.ovp = outp + O_VP + (size_t)l * 16777216; E.oks = outp + O_KS + (size_t)l * 524288; E.ovs = outp + O_VS + (size_t)l * 524288;
            E.ogcp = outp + O_GCP + (size_t)l * 9216; E.ogcs = outp + O_GCS + (size_t)l * 73728;

#ifndef NO_G1
            pg8::gemm_phase<EpiIn, true, true>(lds3, g, S, E, wave_s);
#endif
        }
        GSYNC();
        {
            PHASE_WS
            IDS
            const float* ck = INP(2) + (size_t)l * 8 * PAST * 1024; const float* cv = INP(3) + (size_t)l * 8 * PAST * 1024;
            bf16_t* KS = (bf16_t*)(ws + WS_KS); bf16_t* VTS = (bf16_t*)(ws + WS_VTS);
            for (size_t i_ = gtid; i_ < (size_t)8 * PAST * 128 * PROBE_MISC; i_ += NGT) { const size_t i = i_ % ((size_t)8 * PAST * 128); const size_t b = i / ((size_t)PAST * 128), rem = i % ((size_t)PAST * 128);
                const f32x4 a = *(const f32x4*)(ck + i * 8), c4 = *(const f32x4*)(ck + i * 8 + 4); st_bf8(KS + b * (size_t)KVS * 1024 + rem * 8, a, c4); }
            float* scr = (float*)(lds + wave * 8448);
            __syncthreads();
            for (int it_ = gw; it_ < 8 * 8 * 4 * 64 * PROBE_MISC; it_ += NGW) { const int it = it_ & 16383; const int kvb = it & 63, dvb = (it >> 6) & 3, hh = (it >> 8) & 7, b = it >> 11;
                transpose_item(cv + ((size_t)(b * PAST + 64 * kvb)) * 1024 + hh * 128 + 32 * dvb, 1024, VTS + ((size_t)((b * 8 + hh) * 128 + 32 * dvb)) * KVS + 64 * kvb, KVS, scr, lane); }
            __syncthreads();
#ifndef NO_PREP
            {
                const bf16_t* KPp = (const bf16_t*)(ws + WS_KP); float mxr = 0.f;
                for (int row = gw; row < TP; row += NGW) { const u32x4 a = *(const u32x4*)(KPp + (size_t)row * 1024 + lane * 16), b = *(const u32x4*)(KPp + (size_t)row * 1024 + lane * 16 + 8);
                    float ss = (bflo(a.x) * bflo(a.x) + bfhi(a.x) * bfhi(a.x)) + (bflo(a.y) * bflo(a.y) + bfhi(a.y) * bfhi(a.y)) + (bflo(a.z) * bflo(a.z) + bfhi(a.z) * bfhi(a.z)) + (bflo(a.w) * bflo(a.w) + bfhi(a.w) * bfhi(a.w))
                             + (bflo(b.x) * bflo(b.x) + bfhi(b.x) * bfhi(b.x)) + (bflo(b.y) * bflo(b.y) + bfhi(b.y) * bfhi(b.y)) + (bflo(b.z) * bflo(b.z) + bfhi(b.z) * bfhi(b.z)) + (bflo(b.w) * bflo(b.w) + bfhi(b.w) * bfhi(b.w));
                    ss += __shfl_xor(ss, 1); ss += __shfl_xor(ss, 2); mxr = fmaxf(mxr, ss); }
                if ((lane & 3) == 0) atomicMax(ctl + 16 + l * 16 + (lane >> 2), __float_as_uint(mxr));
            }
#endif
        }
        GSYNC();
        {
            PHASE_WS
            float lam, lam0;
            { float s1 = 0.f, s2 = 0.f;
              const float* q1 = INP(9) + l * 64; const float* k1 = INP(10) + l * 64; const float* q2 = INP(11) + l * 64; const float* k2 = INP(12) + l * 64;
              for (int i = 0; i < 64; ++i) { s1 += q1[i] * k1[i]; s2 += q2[i] * k2[i]; }
              lam0 = uni(0.8f - 0.6f * __expf(-0.3f * (float)l)); lam = uni(__expf(s1) - __expf(s2) + lam0); }
            if (fresh_tid(wave_s) == 0) { ((float*)s_item_p)[1] = lam; ((float*)s_item_p)[2] = 1.f - lam0; }
            const float* subg = INP(13) + l * 128;
            for (;;) {
                __syncthreads();
                if (fresh_tid(wave_s) == 0) s_item = (int)atomicAdd(ctl + l, 1u);
                __syncthreads();
                asm volatile("" : "+s"(ws), "+s"(outp));
                int it = __builtin_amdgcn_readfirstlane(s_item);
                if (it >= 2760) break;
                int kind, idx;
                if (it < 8) { kind = 0; idx = it; }
                else if (it < 72) { kind = 3; idx = it - 8; }
                else if (it < 328) { kind = 1; idx = it - 72; }
                else if (it < 392) { kind = 2; idx = it - 328; }
                else if (it < 2464) { const int r = it - 392, blk = r / 296, o = r - blk * 296; if (o < 64) { kind = 3; idx = 64 + blk * 64 + o; } else { kind = 1; idx = 256 + blk * 232 + (o - 64); } }
                else if (it < 2696) { kind = 1; idx = 1880 + (it - 2464); }
                else { kind = 4; idx = it - 2696; }
                unsigned* rdyb = ctl + 8192 + l * 2112;
                if (kind == 0) {
                    gdn_scan_unit(lds, ws, INP(17) + l * 128, 0, 256, idx, nullptr, outp + O_GP + (size_t)l * 131072 + (size_t)idx * 16384, wave_s, rdyb + idx * 264);
                } else if (kind == 1) {
                    gdn_prep_unit(lds, p, l, idx >> 3, idx & 7, wave_s);
                } else if (kind == 2) {
                    const int b = idx >> 3, h = idx & 7; const float sl2 = uni(exp2f(-(float)(h + 1)) * LOG2E);
                    attn_unit(lds, (const bf16_t*)(ws + WS_QA) + (size_t)(TP + 64 * b) * 1024 + h * 128, (const bf16_t*)(ws + WS_KS) + (size_t)b * KVS * 1024 + h * 128,
                              (const bf16_t*)(ws + WS_VTS) + (size_t)((b * 8 + h) * 128) * KVS, KVS, (bf16_t*)(ws + WS_OA) + (size_t)(TP + 64 * b) * 1024 + h * 128,
                              2, PAST, 65, sl2, (const float*)s_item_p + 1, subg, wave_s, nullptr);
                } else if (kind == 3) {
                    const int qb = 63 - (idx >> 3), h = idx & 7; const float sl2 = uni(exp2f(-(float)(h + 1)) * LOG2E);
                    attn_unit(lds, (const bf16_t*)(ws + WS_QA) + (size_t)(256 * qb) * 1024 + h * 128, (const bf16_t*)(ws + WS_KP) + h * 128,
                              (const bf16_t*)(ws + WS_VTP) + (size_t)(h * 128) * TP, TP, (bf16_t*)(ws + WS_OA) + (size_t)(256 * qb) * 1024 + h * 128,
                              8, 256 * qb, 4 * qb + 4, sl2, (const float*)s_item_p + 1, subg, wave_s, ctl + 16 + l * 16 + h * 2);
                } else {
                    const int b = idx >> 3, h = idx & 7;
                    gdn_scan_unit(lds, ws, INP(17) + l * 128, 256 + b, 1, h, INP(4) + ((size_t)(l * 8 + b) * 8 + h) * 16384, outp + O_GS + (size_t)l * 1048576 + ((size_t)b * 8 + h) * 16384, wave_s, rdyb + h * 264 + 256 + b);
                }
            }
        }
        GSYNC();
        {
            PHASE_WS
            pg8::StaticOrder S; S.init(M, 1024, G, bid);
            { pg8::Gemm g{(const bf16_t*)(ws + WS_OA), (const bf16_t*)(wl + 19 * MiB), M, 1024, 1024}; EpiGateA E{(const bf16_t*)(ws + WS_GA), (float*)(ws + WS_MG)};

#if !defined(NO_G2) && !defined(NO_G2A)
              pg8::gemm_phase<EpiGateA, true, true>(lds3, g, S, E, wave_s);
#endif
 }
            __syncthreads();
            { pg8::Gemm g{(const bf16_t*)(ws + WS_OB), (const bf16_t*)(wl + 21 * MiB), M, 1024, 1024}; EpiGateB E{(const bf16_t*)(ws + WS_GB), (const float*)(ws + WS_MG), (bf16_t*)(ws + WS_MERGED)};

#if !defined(NO_G2) && !defined(NO_G2B)
              pg8::gemm_phase<EpiGateB, true, true>(lds3, g, S, E, wave_s);
#endif
 }
        }
        GSYNC();
        {
            PHASE_WS
            pg8::Gemm g{(const bf16_t*)(ws + WS_MERGED), (const bf16_t*)(wl + 23 * MiB), M, 1024, 1024}; pg8::StaticOrder S; S.init(M, 1024, G, bid);
            EpiRes E{X, INP(21) + l * 1024, XN, ssq + (size_t)(2 * l + 1) * M * 16};
#if !defined(NO_G2) && !defined(NO_G2R)
            pg8::gemm_phase<EpiRes, true, true>(lds3, g, S, E, wave_s);
#endif
        }
        GSYNC();
        {
            PHASE_WS
            pg8::Gemm g{XN, (const bf16_t*)(wl + 25 * MiB), M, FF2, 1024}; pg8::StaticOrder S; S.init(M, FF2, G, bid);
            EpiUp E{ssq + (size_t)(2 * l + 1) * M * 16, (bf16_t*)(ws + WS_U), outp + O_FCP + (size_t)l * 11264, outp + O_FCS + (size_t)l * 90112};
#if !defined(NO_G2) && !defined(NO_G2U)
            pg8::gemm_phase<EpiUp, true, true>(lds3, g, S, E, wave_s);
#endif
        }
        GSYNC();
        {
            PHASE_WS
            IDS
            const bf16_t* U = (const bf16_t*)(ws + WS_U); bf16_t* ACT = (bf16_t*)(ws + WS_ACT);
            const float* cw = INP(23) + (size_t)l * 3 * FF2; const float* cb = INP(24) + (size_t)l * FF2;
            for (size_t it_ = gtid; it_ < (size_t)(M / 16) * 352 * PROBE_MISC; it_ += NGT) { const size_t it = it_ % ((size_t)(M / 16) * 352);
                const int seg = (int)(it / 352), cg8 = (int)(it % 352), f0 = cg8 * 8, r0 = seg * 16;
                float wg[3][8], wv[3][8], bg[8], bv[8];
#pragma unroll
                for (int j = 0; j < 8; ++j) { bg[j] = cb[f0 + j]; bv[j] = cb[FF + f0 + j];
#pragma unroll
                    for (int k = 0; k < 3; ++k) { wg[k][j] = cw[k * FF2 + f0 + j]; wv[k][j] = cw[k * FF2 + FF + f0 + j]; } }
                float g2[8], g1[8], v2[8], v1[8];
                const bool samp = r0 >= TP; const int spos = samp ? ((r0 - TP) & 63) : r0;
                if (spos == 0) {
                    if (samp) { const float* sc = INP(6) + ((size_t)(l * 8 + ((r0 - TP) >> 6)) * 2) * FF2;
#pragma unroll
                        for (int j = 0; j < 8; ++j) { g2[j] = sc[f0 + j]; v2[j] = sc[FF + f0 + j]; g1[j] = sc[FF2 + f0 + j]; v1[j] = sc[FF2 + FF + f0 + j]; } }
                    else {
#pragma unroll
                        for (int j = 0; j < 8; ++j) { g2[j] = 0.f; v2[j] = 0.f; g1[j] = 0.f; v1[j] = 0.f; } }
                } else {
                    const u32x4 a2 = *(const u32x4*)(U + (size_t)(r0 - 2) * FF2 + f0), b2 = *(const u32x4*)(U + (size_t)(r0 - 2) * FF2 + FF + f0);
                    const u32x4 a1 = *(const u32x4*)(U + (size_t)(r0 - 1) * FF2 + f0), b1 = *(const u32x4*)(U + (size_t)(r0 - 1) * FF2 + FF + f0);
                    g2[0] = bflo(a2.x); g2[1] = bfhi(a2.x); g2[2] = bflo(a2.y); g2[3] = bfhi(a2.y); g2[4] = bflo(a2.z); g2[5] = bfhi(a2.z); g2[6] = bflo(a2.w); g2[7] = bfhi(a2.w);
                    v2[0] = bflo(b2.x); v2[1] = bfhi(b2.x); v2[2] = bflo(b2.y); v2[3] = bfhi(b2.y); v2[4] = bflo(b2.z); v2[5] = bfhi(b2.z); v2[6] = bflo(b2.w); v2[7] = bfhi(b2.w);
                    g1[0] = bflo(a1.x); g1[1] = bfhi(a1.x); g1[2] = bflo(a1.y); g1[3] = bfhi(a1.y); g1[4] = bflo(a1.z); g1[5] = bfhi(a1.z); g1[6] = bflo(a1.w); g1[7] = bfhi(a1.w);
                    v1[0] = bflo(b1.x); v1[1] = bfhi(b1.x); v1[2] = bflo(b1.y); v1[3] = bfhi(b1.y); v1[4] = bflo(b1.z); v1[5] = bfhi(b1.z); v1[6] = bflo(b1.w); v1[7] = bfhi(b1.w);
                }
#pragma unroll 4
                for (int rr = 0; rr < 16; ++rr) {
                    const size_t row = (size_t)(r0 + rr);
                    const u32x4 a0 = *(const u32x4*)(U + row * FF2 + f0), b0 = *(const u32x4*)(U + row * FF2 + FF + f0);
                    float g0[8], v0[8], o[8];
                    g0[0] = bflo(a0.x); g0[1] = bfhi(a0.x); g0[2] = bflo(a0.y); g0[3] = bfhi(a0.y); g0[4] = bflo(a0.z); g0[5] = bfhi(a0.z); g0[6] = bflo(a0.w); g0[7] = bfhi(a0.w);
                    v0[0] = bflo(b0.x); v0[1] = bfhi(b0.x); v0[2] = bflo(b0.y); v0[3] = bfhi(b0.y); v0[4] = bflo(b0.z); v0[5] = bfhi(b0.z); v0[6] = bflo(b0.w); v0[7] = bfhi(b0.w);
#pragma unroll
                    for (int j = 0; j < 8; ++j) { const float gc = wg[0][j] * g2[j] + wg[1][j] * g1[j] + wg[2][j] * g0[j] + bg[j]; const float vc = wv[0][j] * v2[j] + wv[1][j] * v1[j] + wv[2][j] * v0[j] + bv[j];
                        o[j] = siluf_(gc) * vc; g2[j] = g1[j]; g1[j] = g0[j]; v2[j] = v1[j]; v1[j] = v0[j]; }
                    u32x4 w; w.x = pk2(o[0], o[1]); w.y = pk2(o[2], o[3]); w.z = pk2(o[4], o[5]); w.w = pk2(o[6], o[7]);
                    *(u32x4*)(ACT + row * FF + f0) = w;
                }
            }
        }
        GSYNC();
        {
            PHASE_WS
            pg8::Gemm g{(const bf16_t*)(ws + WS_ACT), (const bf16_t*)(wl + 36 * MiB), M, 1024, FF}; pg8::StaticOrder S; S.init(M, 1024, G, bid);
            EpiRes E{X, l == 0 ? INP(7) + 1024 : INP(26), XN, ssq + (size_t)(2 * l + 2) * M * 16};
#if !defined(NO_G2) && !defined(NO_G2R)
            pg8::gemm_phase<EpiRes, true, true>(lds3, g, S, E, wave_s);
#endif
        }
        GSYNC();
#undef s_item
}

__global__ void __launch_bounds__(512, 2) hybrid_fwd(Params p) {
    extern __shared__ __attribute__((aligned(16))) unsigned char lds[];
    cg::grid_group grid = cg::this_grid();
    const int wave_s = __builtin_amdgcn_readfirstlane((int)(threadIdx.x >> 6));
    const int G = gridDim.x, bid = blockIdx.x;
    const int NGW = G * 8; const size_t NGT = (size_t)G * 512;
    unsigned char* ws = p.ws;
    unsigned* ctl = (unsigned*)(ws + WS_CTL);
    float* ssq = (float*)(ws + WS_SSP);
    float* X = (float*)(ws + WS_X); bf16_t* XN = (bf16_t*)(ws + WS_XN);
    LAS unsigned char* lds3 = (LAS unsigned char*)lds;
    __shared__ int s_item[8];

    if (fresh_tid(wave_s) == 0) { s_item[4] = 0; s_item[5] = 0; }
    __syncthreads();
    const XcdBarrier xbar = xcd_barrier_post(ctl + 4096, (volatile LAS unsigned*)(LAS int*)s_item + 4, fresh_tid(wave_s) == 0);
    {
    IDS
    {
        float* scr = (float*)(lds + wave * 8448);
        constexpr int I_A = 16 * 192, I_B = 16 * 96, I_P = 16 * 32, I_UP = 16 * 176, I_DN = 44 * 32;
        constexpr int PER_L = I_A + I_B + 3 * I_P + I_UP + I_DN;
        for (int it_ = gw; it_ < 2 * PER_L * PROBE_MISC; it_ += NGW) { const int it = it_ % (2 * PER_L);
            const int l = it / PER_L; int r = it % PER_L;
            unsigned char* wl = ws + WS_W + (size_t)l * W_LSTRIDE;
            const float* src; size_t sp; bf16_t* dst; size_t dp; int kb, nb;
            if (r < I_A) { kb = r / 192; nb = r % 192; src = INP(8) + (size_t)l * 1024 * 9232 + (size_t)(64 * kb) * 9232 + 32 * nb; sp = 9232; dst = (bf16_t*)wl + (size_t)(32 * nb) * 1024 + 64 * kb; dp = 1024; }
            else if ((r -= I_A) < I_B) { kb = r / 96; nb = r % 96; src = INP(8) + (size_t)l * 1024 * 9232 + (size_t)(64 * kb) * 9232 + 6160 + 32 * nb; sp = 9232; dst = (bf16_t*)wl + (size_t)(6144 + 32 * nb) * 1024 + 64 * kb; dp = 1024; }
            else if ((r -= I_B) < I_P) { kb = r / 32; nb = r % 32; src = INP(18) + (size_t)l * 1024 * 1024 + (size_t)(64 * kb) * 1024 + 32 * nb; sp = 1024; dst = (bf16_t*)(wl + 19 * MiB) + (size_t)(32 * nb) * 1024 + 64 * kb; dp = 1024; }
            else if ((r -= I_P) < I_P) { kb = r / 32; nb = r % 32; src = INP(19) + (size_t)l * 1024 * 1024 + (size_t)(64 * kb) * 1024 + 32 * nb; sp = 1024; dst = (bf16_t*)(wl + 21 * MiB) + (size_t)(32 * nb) * 1024 + 64 * kb; dp = 1024; }
            else if ((r -= I_P) < I_P) { kb = r / 32; nb = r % 32; src = INP(20) + (size_t)l * 1024 * 1024 + (size_t)(64 * kb) * 1024 + 32 * nb; sp = 1024; dst = (bf16_t*)(wl + 23 * MiB) + (size_t)(32 * nb) * 1024 + 64 * kb; dp = 1024; }
            else if ((r -= I_P) < I_UP) { kb = r / 176; nb = r % 176; src = INP(22) + (size_t)l * 1024 * FF2 + (size_t)(64 * kb) * FF2 + 32 * nb; sp = FF2; dst = (bf16_t*)(wl + 25 * MiB) + (size_t)(32 * nb) * 1024 + 64 * kb; dp = 1024; }
            else { r -= I_UP; kb = r / 32; nb = r % 32; src = INP(25) + (size_t)l * FF * 1024 + (size_t)(64 * kb) * 1024 + 32 * nb; sp = 1024; dst = (bf16_t*)(wl + 36 * MiB) + (size_t)(32 * nb) * FF + 64 * kb; dp = FF; }
            transpose_item(src, sp, dst, dp, scr, lane);
        }
        const float* win = INP(8);
        for (size_t i = gtid; i < 2 * 16 * 1024; i += NGT) { const int l = (int)(i >> 14), j = (int)((i >> 10) & 15), k = (int)(i & 1023);
            ((bf16_t*)(ws + WS_W + (size_t)l * W_LSTRIDE))[(size_t)(9216 + j) * 1024 + k] = (bf16_t)f2bf(win[(size_t)l * 1024 * 9232 + (size_t)k * 9232 + 6144 + j]); }
        const float* g0 = INP(7); const float* xin0 = INP(0); const float* xin1 = INP(1);
        for (int mrow_ = gw; mrow_ < M * PROBE_MISC; mrow_ += NGW) { const int mrow = mrow_ % M;
            const float* xr = mrow < TP ? xin0 + (size_t)mrow * 1024 : xin1 + (size_t)(mrow - TP) * 1024;
            float s = 0.f;
#pragma unroll
            for (int j = 0; j < 4; ++j) { const int c = 4 * lane + 256 * j; const f32x4 v = *(const f32x4*)(xr + c); const f32x4 gg = *(const f32x4*)(g0 + c);
                *(f32x4*)(X + (size_t)mrow * 1024 + c) = v; s += (v[0] * v[0] + v[1] * v[1]) + (v[2] * v[2] + v[3] * v[3]);
                u32x2 w; w.x = pk2(v[0] * gg[0], v[1] * gg[1]); w.y = pk2(v[2] * gg[2], v[3] * gg[3]); *(u32x2*)(XN + (size_t)mrow * 1024 + c) = w; }
            s = wave_sum(s); if (lane < 16) ssq[(size_t)mrow * 16 + lane] = lane == 0 ? s : 0.f;
        }
    }
    }
    asm volatile("s_waitcnt vmcnt(0) lgkmcnt(0)" ::: "memory"); grid.sync();

    layer_body<0>(p, lds, s_item, wave_s, xbar);
    layer_body<1>(p, lds, s_item, wave_s, xbar);
    {
        IDS
        const float* gf = INP(26); const float* ss4 = ssq + (size_t)4 * M * 16;
        for (size_t i_ = gtid; i_ < (size_t)M * 256 * PROBE_MISC; i_ += NGT) { const size_t i = i_ % ((size_t)M * 256); const size_t row = i >> 8; const int c = (int)(i & 255) * 4;
            const float rs = rsqrtf(ss16(ss4 + row * 16) * (1.f / 1024.f) + EPS); const f32x4 v = *(const f32x4*)(X + row * 1024 + c); const f32x4 gg = *(const f32x4*)(gf + c);
            *(f32x4*)(p.out + O_YP + row * 1024 + c) = v * rs * gg; }
    }
}

extern "C" void kernel_launch(void* const* d_in, const int* in_sizes, int n_in, void* d_out, int out_size, void* d_ws, size_t ws_size, hipStream_t stream) {
    static int grid_blocks = 0;
    if (!grid_blocks) {
        int dev = 0, cus = 0, per_cu = 0;
        hipGetDevice(&dev);
        hipDeviceGetAttribute(&cus, hipDeviceAttributeMultiprocessorCount, dev);
        hipFuncSetAttribute((const void*)hybrid_fwd, hipFuncAttributeMaxDynamicSharedMemorySize, LDS_BYTES);
        hipOccupancyMaxActiveBlocksPerMultiprocessor(&per_cu, (const void*)hybrid_fwd, 512, LDS_BYTES);
        if (per_cu < 1) per_cu = 1;
        if (per_cu > 1) per_cu = 1;
        grid_blocks = cus * per_cu;
        (void)hipGetLastError();
    }
    Params p{};
    for (int i = 0; i < 27; ++i) p.in[i] = (const float*)d_in[i];
    p.out = (float*)d_out; p.ws = (unsigned char*)d_ws;
    (void)hipMemsetAsync(d_ws, 0, 65536, stream);
    void* args[] = {&p};
    hipError_t e = hipLaunchCooperativeKernel((const void*)hybrid_fwd, dim3(grid_blocks), dim3(512), args, LDS_BYTES, stream);
    if (e != hipSuccess) fprintf(stderr, "cooperative launch failed: %s (grid %d)\n", hipGetErrorString(e), grid_blocks);
}
```
